# Optimizing an MI355X kernel written in HIP

```python
import jax, jax.numpy as jnp
from jax import lax
import numpy as np

D_MODEL = 1024
BATCH = 2
SEQ = 8192
DEPTH = 2

HEAD_DIM = 64
FOX_HEADS = 8
NSA_HEADS = 8
NSA_KV_HEADS = 2
NSA_GROUP = NSA_HEADS // NSA_KV_HEADS
CMP_BLOCK = 32
CMP_STRIDE = 16
CMP_HIDDEN = 4 * HEAD_DIM
SEL_BLOCK = 64
SEL_TOPK = 16
WINDOW = 512
Q_BLOCK = 128
ROPE_THETA = 500000.0
ROPE_DIM = HEAD_DIM // 4
D_FF = 4 * D_MODEL
RMS_EPS = 1e-6
FORGET_BIAS_INIT = 3.0
FORCE_SCORE = 1e6
NEG_BIG = -1e30

FOX_W = FOX_HEADS * HEAD_DIM
NSA_W = NSA_HEADS * HEAD_DIM
KV_W = NSA_KV_HEADS * HEAD_DIM
SPLITS = (FOX_W, FOX_W, FOX_W, FOX_HEADS, NSA_W, 6 * KV_W, 3 * NSA_HEADS, D_MODEL, D_MODEL)
D_IN = sum(SPLITS)

kernel_name = 'hybrid_fox_nsa_block'


def rmsnorm(x, g):
    xf = x.astype(jnp.float32)
    y = xf * lax.rsqrt(jnp.mean(xf * xf, axis=-1, keepdims=True) + RMS_EPS)
    return (y * g.astype(jnp.float32)).astype(x.dtype)


def partial_rope(t, pos):
    half = ROPE_DIM // 2
    inv = ROPE_THETA ** (-jnp.arange(half, dtype=jnp.float32) / half)
    ang = pos.astype(jnp.float32)[:, None] * inv[None, :]
    cos, sin = jnp.cos(ang), jnp.sin(ang)
    x1 = t[..., :half].astype(jnp.float32)
    x2 = t[..., half:ROPE_DIM].astype(jnp.float32)
    rot = jnp.concatenate([x1 * cos - x2 * sin, x2 * cos + x1 * sin], axis=-1)
    return jnp.concatenate([rot.astype(t.dtype), t[..., ROPE_DIM:]], axis=-1)


def to_heads(t, n):
    B, T, _ = t.shape
    return t.reshape(B, T, n, HEAD_DIM).transpose(0, 2, 1, 3)


def from_heads(o):
    B, H, T, dh = o.shape
    return o.transpose(0, 2, 1, 3).reshape(B, T, H * dh)


def n_cmp_blocks(T):
    return (T - CMP_BLOCK) // CMP_STRIDE + 1


def cmp_end_positions(T):
    return jnp.arange(n_cmp_blocks(T)) * CMP_STRIDE + CMP_BLOCK - 1


def cmp_to_sel_matrix(T):
    nc, n_sel = n_cmp_blocks(T), T // SEL_BLOCK
    cs = np.arange(nc) * CMP_STRIDE
    ce = cs + CMP_BLOCK
    ss = np.arange(n_sel) * SEL_BLOCK
    se = ss + SEL_BLOCK
    ov = np.clip(np.minimum(ce[:, None], se[None, :]) - np.maximum(cs[:, None], ss[None, :]), 0, None)
    return (ov / CMP_BLOCK).astype(np.float32)


def fox_attention(q, k, v, log_f):
    B, H, T, dh = q.shape
    c = jnp.cumsum(log_f, axis=-1)
    nb = T // Q_BLOCK
    qb = q.reshape(B, H, nb, Q_BLOCK, dh).transpose(2, 0, 1, 3, 4)
    cb = c.reshape(B, H, nb, Q_BLOCK).transpose(2, 0, 1, 3)
    kpos = jnp.arange(T)
    scale = HEAD_DIM ** -0.5

    def block(args):
        i, qi, ci = args
        qpos = i * Q_BLOCK + jnp.arange(Q_BLOCK)
        s = jnp.einsum('bhqd,bhkd->bhqk', qi, k, preferred_element_type=jnp.float32) * scale
        s = s + ci[..., :, None] - c[..., None, :]
        s = jnp.where(kpos[None, :] <= qpos[:, None], s, -jnp.inf)
        p = jax.nn.softmax(s, axis=-1)
        return jnp.einsum('bhqk,bhkd->bhqd', p.astype(v.dtype), v)

    out = lax.map(block, (jnp.arange(nb), qb, cb))
    return out.transpose(1, 2, 0, 3, 4).reshape(B, H, T, dh)


def compress_blocks(t, pos_emb, w1, b1, w2, b2):
    B, G, T, dh = t.shape
    nc = n_cmp_blocks(T)
    idx = np.arange(nc)[:, None] * CMP_STRIDE + np.arange(CMP_BLOCK)[None, :]
    blocks = t[:, :, idx, :] + pos_emb
    flat = blocks.reshape(B, G, nc, CMP_BLOCK * dh)
    return jax.nn.gelu(flat @ w1 + b1) @ w2 + b2


def nsa_attention(q, kc, vc, ks, vs, kw, vw):
    B, G, R, T, dh = q.shape
    n_sel = T // SEL_BLOCK
    top = min(SEL_TOPK, n_sel)
    nb = T // Q_BLOCK
    scale = HEAD_DIM ** -0.5
    cmp_end = cmp_end_positions(T)
    sel_map = jnp.asarray(cmp_to_sel_matrix(T))
    ks_blocks = ks.reshape(B, G, n_sel, SEL_BLOCK, dh)
    vs_blocks = vs.reshape(B, G, n_sel, SEL_BLOCK, dh)
    pad = ((0, 0), (0, 0), (WINDOW, 0), (0, 0))
    kw_pad = jnp.pad(kw, pad)
    vw_pad = jnp.pad(vw, pad)
    gather = jax.vmap(jax.vmap(lambda blocks, ix: blocks[ix]))
    qb = q.reshape(B, G, R, nb, Q_BLOCK, dh).transpose(3, 0, 1, 2, 4, 5)
    sel_ids = jnp.arange(n_sel)
    blk_start = sel_ids * SEL_BLOCK

    def block(args):
        i, qi = args
        q0 = i * Q_BLOCK
        qpos = q0 + jnp.arange(Q_BLOCK)
        s = jnp.einsum('bgrqd,bgnd->bgrqn', qi, kc, preferred_element_type=jnp.float32) * scale
        valid_c = cmp_end[None, :] <= qpos[:, None]
        p_c = jax.nn.softmax(jnp.where(valid_c, s, NEG_BIG), axis=-1) * valid_c
        o_c = jnp.einsum('bgrqn,bgnd->bgrqd', p_c.astype(vc.dtype), vc)
        imp = jnp.einsum('bgrqn,ns->bgqs', p_c, sel_map)
        future = blk_start[None, :] > qpos[:, None]
        forced = (sel_ids[None, :] == (qpos // SEL_BLOCK)[:, None]) | (sel_ids[None, :] == 0)
        imp = jnp.where(future, -1.0, jnp.where(forced, FORCE_SCORE, imp))
        _, idx = lax.top_k(imp, top)
        kg = gather(ks_blocks, idx).reshape(B, G, Q_BLOCK, top * SEL_BLOCK, dh)
        vg = gather(vs_blocks, idx).reshape(B, G, Q_BLOCK, top * SEL_BLOCK, dh)
        kpos = (idx[..., None] * SEL_BLOCK + jnp.arange(SEL_BLOCK)).reshape(B, G, Q_BLOCK, top * SEL_BLOCK)
        valid_s = kpos <= qpos[None, None, :, None]
        s = jnp.einsum('bgrqd,bgqkd->bgrqk', qi, kg, preferred_element_type=jnp.float32) * scale
        p_s = jax.nn.softmax(jnp.where(valid_s[:, :, None], s, -jnp.inf), axis=-1)
        o_s = jnp.einsum('bgrqk,bgqkd->bgrqd', p_s.astype(vg.dtype), vg)
        kwin = lax.dynamic_slice_in_dim(kw_pad, q0, WINDOW + Q_BLOCK, axis=2)
        vwin = lax.dynamic_slice_in_dim(vw_pad, q0, WINDOW + Q_BLOCK, axis=2)
        kpos_w = q0 - WINDOW + jnp.arange(WINDOW + Q_BLOCK)
        diff = qpos[:, None] - kpos_w[None, :]
        valid_w = (kpos_w[None, :] >= 0) & (diff >= 0) & (diff < WINDOW)
        s = jnp.einsum('bgrqd,bgkd->bgrqk', qi, kwin, preferred_element_type=jnp.float32) * scale
        p_w = jax.nn.softmax(jnp.where(valid_w, s, -jnp.inf), axis=-1)
        o_w = jnp.einsum('bgrqk,bgkd->bgrqd', p_w.astype(vwin.dtype), vwin)
        return o_c, o_s, o_w

    o_c, o_s, o_w = lax.map(block, (jnp.arange(nb), qb))
    unblock = lambda o: o.transpose(1, 2, 3, 0, 4, 5).reshape(B, G, R, T, dh)
    return unblock(o_c), unblock(o_s), unblock(o_w)


def hybrid_layer(x, norm_mix, w_in, b_forget, cmp_pos, cmp_w1, cmp_b1, cmp_w2, cmp_b2,
                 w_o_fox, w_o_nsa, w_out, norm_mlp, w_up, w_down):
    B, T, _ = x.shape
    h = rmsnorm(x, norm_mix)
    proj = h @ w_in
    q_a, k_a, v_a, f_a, q_b, kv_b, g_b, gate_a, gate_b = jnp.split(
        proj, np.cumsum(SPLITS)[:-1].tolist(), axis=-1)
    log_f = jax.nn.log_sigmoid((f_a + b_forget).astype(jnp.float32)).transpose(0, 2, 1)
    o_a = fox_attention(to_heads(q_a, FOX_HEADS), to_heads(k_a, FOX_HEADS), to_heads(v_a, FOX_HEADS), log_f)
    y_a = from_heads(o_a) @ w_o_fox
    pos = jnp.arange(T)
    q_n = partial_rope(to_heads(q_b, NSA_HEADS), pos).reshape(B, NSA_KV_HEADS, NSA_GROUP, T, HEAD_DIM)
    kc, vc, ks, vs, kw, vw = [to_heads(t, NSA_KV_HEADS) for t in jnp.split(kv_b, 6, axis=-1)]
    kc = compress_blocks(kc, cmp_pos[0], cmp_w1[0], cmp_b1[0], cmp_w2[0], cmp_b2[0])
    kc = partial_rope(kc, cmp_end_positions(T))
    vc = compress_blocks(vc, cmp_pos[1], cmp_w1[1], cmp_b1[1], cmp_w2[1], cmp_b2[1])
    ks = partial_rope(ks, pos)
    kw = partial_rope(kw, pos)
    o_c, o_s, o_w = nsa_attention(q_n, kc, vc, ks, vs, kw, vw)
    g = jax.nn.sigmoid(g_b).reshape(B, T, NSA_HEADS, 3).transpose(0, 2, 1, 3)
    g = g.reshape(B, NSA_KV_HEADS, NSA_GROUP, T, 3)
    o_n = g[..., 0:1] * o_c + g[..., 1:2] * o_s + g[..., 2:3] * o_w
    y_b = from_heads(o_n.reshape(B, NSA_HEADS, T, HEAD_DIM)) @ w_o_nsa
    mixed = jax.nn.sigmoid(gate_a) * y_a + jax.nn.sigmoid(gate_b) * y_b
    x = x + mixed @ w_out
    h = rmsnorm(x, norm_mlp)
    return x + jnp.square(jax.nn.relu(h @ w_up)) @ w_down


def setup_inputs(seed: int = 0) -> dict:
    key = jax.random.key(seed)
    ks = jax.random.split(key, 17)
    f32 = jnp.float32
    nrm = lambda k, shape, fan_in: jax.random.normal(k, shape, f32) * fan_in ** -0.5
    return {
        'x': jax.random.normal(ks[0], (BATCH, SEQ, D_MODEL), f32),
        'norm_mix': 1.0 + 0.02 * jax.random.normal(ks[1], (DEPTH, D_MODEL), f32),
        'w_in': nrm(ks[2], (DEPTH, D_MODEL, D_IN), D_MODEL),
        'b_forget': FORGET_BIAS_INIT + 0.1 * jax.random.normal(ks[3], (DEPTH, FOX_HEADS), f32),
        'cmp_pos': 0.02 * jax.random.normal(ks[4], (DEPTH, 2, CMP_BLOCK, HEAD_DIM), f32),
        'cmp_w1': nrm(ks[5], (DEPTH, 2, CMP_BLOCK * HEAD_DIM, CMP_HIDDEN), CMP_BLOCK * HEAD_DIM),
        'cmp_b1': 0.02 * jax.random.normal(ks[6], (DEPTH, 2, CMP_HIDDEN), f32),
        'cmp_w2': nrm(ks[7], (DEPTH, 2, CMP_HIDDEN, HEAD_DIM), CMP_HIDDEN),
        'cmp_b2': 0.02 * jax.random.normal(ks[8], (DEPTH, 2, HEAD_DIM), f32),
        'w_o_fox': nrm(ks[9], (DEPTH, FOX_W, D_MODEL), FOX_W),
        'w_o_nsa': nrm(ks[10], (DEPTH, NSA_W, D_MODEL), NSA_W),
        'w_out': nrm(ks[11], (DEPTH, D_MODEL, D_MODEL), D_MODEL),
        'norm_mlp': 1.0 + 0.02 * jax.random.normal(ks[12], (DEPTH, D_MODEL), f32),
        'w_up': nrm(ks[13], (DEPTH, D_MODEL, D_FF), D_MODEL),
        'w_down': 0.5 * nrm(ks[14], (DEPTH, D_FF, D_MODEL), D_FF),
        'norm_final': 1.0 + 0.02 * jax.random.normal(ks[15], (D_MODEL,), f32),
    }


def reference(x, norm_mix, w_in, b_forget, cmp_pos, cmp_w1, cmp_b1, cmp_w2, cmp_b2,
              w_o_fox, w_o_nsa, w_out, norm_mlp, w_up, w_down, norm_final):
    for l in range(DEPTH):
        x = hybrid_layer(x, norm_mix[l], w_in[l], b_forget[l], cmp_pos[l], cmp_w1[l], cmp_b1[l],
                         cmp_w2[l], cmp_b2[l], w_o_fox[l], w_o_nsa[l], w_out[l],
                         norm_mlp[l], w_up[l], w_down[l])
    return rmsnorm(x, norm_final)
```

```cpp
#include <hip/hip_runtime.h>
#include <hip/hip_cooperative_groups.h>
#include <cstdio>
#include <cstdint>
#include <cmath>
namespace cg = cooperative_groups;
namespace pg8 {
#define PG8_LAS __attribute__((address_space(3)))
typedef unsigned short bf16_t;
typedef short bf16x8 __attribute__((ext_vector_type(8)));
typedef float f32x4 __attribute__((ext_vector_type(4)));
typedef unsigned u32x4 __attribute__((ext_vector_type(4)));
constexpr int BM = 256, BK = 64, HALF = 128, HTB = HALF * BK * 2  , STAGE_BYTES = 8 * HTB, NXCD = 8, WGM = 8;

__host__ __device__ __forceinline__ int lds_byte(int r, int c) { const int st = (r >> 4) * 2 + (c >> 5), rr = r & 15, cc = c & 31, ob = rr * 64 + cc * 2; return st * 1024 + (ob ^ (((ob >> 9) & 1) << 5)); }
__host__ __device__ __forceinline__ void stage_rc(int b, int& R, int& C) { const int st = b / 1024, sb = b % 1024, swz = sb ^ (((sb >> 9) & 1) << 5); R = (st >> 1) * 16 + swz / 64; C = (st & 1) * 32 + (swz % 64) / 2; }
__host__ __device__ __forceinline__ int perm32(int rho) { const int n = rho >> 4, i = rho & 15; return 8 * (i >> 2) + 4 * n + (i & 3); }

struct Unit { int pm, pn; };
struct Gemm { const bf16_t* A; const bf16_t* Bt; int M, N, K; };

struct StaticOrder {
    int nM, nN, nwg, G, c;
    __host__ __device__ void init(int M, int N, int G_, int c_) { nM = M / BM; nN = N / BM; nwg = nM * nN; G = G_; c = c_; }
    __host__ __device__ bool next(int i, Unit& u) const {
        const long L = (long)i * G + c; if (L >= nwg) return false;
        int wgid = (int)L; { const int q = nwg / NXCD, r = nwg % NXCD, xcd = wgid % NXCD, off = wgid / NXCD; wgid = (xcd < r ? xcd * (q + 1) : r * (q + 1) + (xcd - r) * q) + off; }
        const int nig = WGM * nN, gid = wgid / nig, fm = gid * WGM, gsz = (nM - fm) < WGM ? (nM - fm) : WGM;
        u.pm = fm + ((wgid % nig) % gsz); u.pn = (wgid % nig) / gsz; return true;
    }
    __device__ __forceinline__ void a_ready(const Unit&) const {}
    __device__ __forceinline__ void done(const Unit&) const {}
};

__device__ __forceinline__ unsigned cvt_pk_bf16(float lo, float hi) { unsigned r; asm volatile("v_cvt_pk_bf16_f32 %0, %1, %2" : "=v"(r) : "v"(lo), "v"(hi)); return r; }

template <class Epi, class Sched, bool ALIGN_EPI = false, bool SP2 = false>
__device__ __forceinline__ void gemm_phase(PG8_LAS unsigned char* lds, const Gemm g, const Sched& S, const Epi& E) {
    int tid_ = threadIdx.x; asm volatile("" : "+v"(tid_));
    const int tid = tid_, wid = __builtin_amdgcn_readfirstlane(tid >> 6), lane = tid & 63, wr = wid >> 2, wc = wid & 3, fr = lane & 15, fq = lane >> 4;
    const int K = g.K, nt = K / BK;
    unsigned voffA[2], voffB[2];
#pragma unroll
    for (int i = 0; i < 2; ++i) { int R, C; stage_rc(tid * 16 + i * 8192, R, C); const int Rb = Epi::PERM ? ((R & ~31) + perm32(R & 31)) : R;
        voffA[i] = (unsigned)(R * K + C) * 2u; voffB[i] = (unsigned)(Rb * K + C) * 2u; }
    const size_t kstep = (size_t)(BK * 2);
    const size_t hstep = (size_t)HALF * K * 2;
    const size_t tstep = 2 * hstep;
    const unsigned ldsw = (unsigned)wid * 1024u;
    const int aoff = lds_byte(wr * 64 + fr, fq * 8), boff = lds_byte(wc * 32 + fr, fq * 8);
#define PG8_SA(b, h) (((b) * 2 + (h)) * HTB)
#define PG8_SB(b, h) ((4 + (b) * 2 + (h)) * HTB)
#define PG8_STAGE(bufoff, gbase, voff) do { _Pragma("unroll") for (int _i = 0; _i < 2; ++_i) \
        __builtin_amdgcn_global_load_lds((const unsigned*)((const char*)(gbase) + (voff)[_i]), (PG8_LAS unsigned*)(lds + (bufoff) + ldsw + _i * 8192), 16, 0, 0); } while (0)
#define PG8_LDA(dst, b, h) do { _Pragma("unroll") for (int m = 0; m < 4; ++m) _Pragma("unroll") for (int k = 0; k < 2; ++k) dst[m][k] = *(const PG8_LAS bf16x8*)(lds + PG8_SA(b, h) + aoff + m * 2048 + k * 1024); } while (0)
#define PG8_LDB(dst, b, h) do { _Pragma("unroll") for (int n = 0; n < 2; ++n) _Pragma("unroll") for (int k = 0; k < 2; ++k) dst[n][k] = *(const PG8_LAS bf16x8*)(lds + PG8_SB(b, h) + boff + n * 2048 + k * 1024); } while (0)
#define PG8_MMA(ai, bj, At, Bt) do { __builtin_amdgcn_s_setprio(1); _Pragma("unroll") for (int m = 0; m < 4; ++m) _Pragma("unroll") for (int n = 0; n < 2; ++n) _Pragma("unroll") for (int k = 0; k < 2; ++k) \
        acc[ai][bj][m][n] = __builtin_amdgcn_mfma_f32_16x16x32_bf16(Bt[n][k], At[m][k], acc[ai][bj][m][n], 0, 0, 0); __builtin_amdgcn_s_setprio(0); } while (0)
#define PG8_WAIT_V(n) asm volatile("s_waitcnt vmcnt(" #n ")" ::: "memory")
#define PG8_WAIT_L(n) asm volatile("s_waitcnt lgkmcnt(" #n ")" ::: "memory")
#define PG8_BAR __builtin_amdgcn_s_barrier()
#define PG8_SCHED __builtin_amdgcn_sched_barrier(0)
    Unit cur, nxt; int ui = 0;
    if (!S.next(0, cur)) return;
    f32x4 acc[2][2][4][2];
#pragma unroll
    for (int a = 0; a < 2; ++a)
#pragma unroll
        for (int b = 0; b < 2; ++b)
#pragma unroll
            for (int m = 0; m < 4; ++m)
#pragma unroll
                for (int n = 0; n < 2; ++n) acc[a][b][m][n] = (f32x4){0.f, 0.f, 0.f, 0.f};
    bf16x8 At[4][2], B0[2][2], B1[2][2];
    const char* cA = (const char*)g.A + (size_t)cur.pm * tstep; const char* cB = (const char*)g.Bt + (size_t)cur.pn * tstep;
    S.a_ready(cur);
    if constexpr (SP2) {
        PG8_STAGE(PG8_SB(0, 0), cB, voffB); PG8_STAGE(PG8_SB(0, 1), cB + hstep, voffB); PG8_STAGE(PG8_SA(0, 0), cA, voffA); PG8_STAGE(PG8_SA(0, 1), cA + hstep, voffA);
        if (wr == 1) PG8_BAR;
        PG8_WAIT_V(2); PG8_BAR;
        PG8_STAGE(PG8_SB(1, 0), cB + kstep, voffB); PG8_STAGE(PG8_SA(1, 0), cA + kstep, voffA); PG8_STAGE(PG8_SB(1, 1), cB + hstep + kstep, voffB);
        PG8_WAIT_V(6); PG8_BAR;
    } else {
        PG8_STAGE(PG8_SB(0, 0), cB, voffB); PG8_STAGE(PG8_SA(0, 0), cA, voffA); PG8_STAGE(PG8_SB(0, 1), cB + hstep, voffB); PG8_STAGE(PG8_SA(0, 1), cA + hstep, voffA);
        if (wr == 1) PG8_BAR;
        PG8_WAIT_V(4); PG8_BAR;
        PG8_STAGE(PG8_SB(1, 0), cB + kstep, voffB); PG8_STAGE(PG8_SA(1, 0), cA + kstep, voffA); PG8_STAGE(PG8_SB(1, 1), cB + hstep + kstep, voffB);
        PG8_WAIT_V(6); PG8_BAR;
    }
    for (;;) {
        const bool has_next = S.next(ui + 1, nxt);
        const char* nA = has_next ? (const char*)g.A + (size_t)nxt.pm * tstep : cA; const char* nB = has_next ? (const char*)g.Bt + (size_t)nxt.pn * tstep : cB;
#pragma unroll 1
        for (int kr_ = 0; kr_ < ((Epi::MID_T >= 0) ? 2 : 1); ++kr_) {
        const int tb_ = (Epi::MID_T >= 0 && kr_ == 1) ? Epi::MID_T : 0, te_ = (Epi::MID_T >= 0 && kr_ == 0) ? Epi::MID_T : nt;
        if constexpr (Epi::MID_T >= 0) { if (kr_ == 1) E.mid(acc, cur, wr, wc, fr, fq); }
        for (int t = tb_; t < te_; t += 2) {
            const bool last = (t == nt - 2);
            const char* a1 = cA + (size_t)(t + 1) * kstep;
            const char* a2 = last ? nA : cA + (size_t)(t + 2) * kstep; const char* b2 = last ? nB : cB + (size_t)(t + 2) * kstep;
            const char* a3 = a2 + kstep; const char* b3 = b2 + kstep;
            if (last && has_next) S.a_ready(nxt);
            if constexpr (SP2) {
            PG8_LDB(B0, 0, 0); PG8_LDB(B1, 0, 1); PG8_SCHED; PG8_LDA(At, 0, 0); PG8_STAGE(PG8_SA(1, 1), a1 + hstep, voffA);
            PG8_WAIT_V(8); PG8_WAIT_L(0); PG8_BAR; PG8_MMA(0, 0, At, B0); PG8_MMA(0, 1, At, B1); PG8_BAR; PG8_SCHED;
            PG8_LDA(At, 0, 1); PG8_STAGE(PG8_SB(0, 0), b2, voffB); PG8_STAGE(PG8_SB(0, 1), b2 + hstep, voffB); PG8_STAGE(PG8_SA(0, 0), a2, voffA);
            PG8_WAIT_V(8); PG8_WAIT_L(0); PG8_BAR; PG8_MMA(1, 0, At, B0); PG8_MMA(1, 1, At, B1); PG8_BAR; PG8_SCHED;
            PG8_LDB(B0, 1, 0); PG8_LDB(B1, 1, 1); PG8_SCHED; PG8_LDA(At, 1, 0); PG8_STAGE(PG8_SA(0, 1), a2 + hstep, voffA);
            PG8_WAIT_V(8); PG8_WAIT_L(0); PG8_BAR; PG8_MMA(0, 0, At, B0); PG8_MMA(0, 1, At, B1); PG8_BAR; PG8_SCHED;
            PG8_LDA(At, 1, 1); PG8_STAGE(PG8_SB(1, 0), b3, voffB); PG8_STAGE(PG8_SB(1, 1), b3 + hstep, voffB); PG8_STAGE(PG8_SA(1, 0), a3, voffA);
            PG8_WAIT_V(8); PG8_WAIT_L(0); PG8_BAR; PG8_MMA(1, 0, At, B0); PG8_MMA(1, 1, At, B1); PG8_BAR; PG8_SCHED;
            } else {
            PG8_LDB(B0, 0, 0); PG8_SCHED; PG8_LDA(At, 0, 0); PG8_STAGE(PG8_SA(1, 1), a1 + hstep, voffA);
            PG8_WAIT_L(8); PG8_BAR; PG8_WAIT_L(0); PG8_MMA(0, 0, At, B0); PG8_BAR; PG8_SCHED;
            PG8_LDB(B1, 0, 1); PG8_STAGE(PG8_SB(0, 0), b2, voffB);
            PG8_BAR; PG8_WAIT_L(0); PG8_MMA(0, 1, At, B1); PG8_BAR;
            PG8_LDA(At, 0, 1); PG8_STAGE(PG8_SA(0, 0), a2, voffA);
            PG8_BAR; PG8_WAIT_L(0); PG8_MMA(1, 0, At, B0); PG8_BAR; PG8_SCHED;
            PG8_STAGE(PG8_SB(0, 1), b2 + hstep, voffB);
            PG8_WAIT_V(6); PG8_BAR; PG8_MMA(1, 1, At, B1); PG8_BAR;
            PG8_LDB(B0, 1, 0); PG8_SCHED; PG8_LDA(At, 1, 0); PG8_STAGE(PG8_SA(0, 1), a2 + hstep, voffA);
            PG8_WAIT_L(8); PG8_BAR; PG8_WAIT_L(0); PG8_MMA(0, 0, At, B0); PG8_BAR; PG8_SCHED;
            PG8_LDB(B1, 1, 1); PG8_STAGE(PG8_SB(1, 0), b3, voffB);
            PG8_BAR; PG8_WAIT_L(0); PG8_MMA(0, 1, At, B1); PG8_BAR;
            PG8_LDA(At, 1, 1); PG8_STAGE(PG8_SA(1, 0), a3, voffA);
            PG8_BAR; PG8_WAIT_L(0); PG8_MMA(1, 0, At, B0); PG8_BAR; PG8_SCHED;
            PG8_STAGE(PG8_SB(1, 1), b3 + hstep, voffB);
            PG8_WAIT_V(6); PG8_BAR; PG8_MMA(1, 1, At, B1); PG8_BAR;
            }
        }
        }
        if constexpr (ALIGN_EPI) { if (wr == 0) PG8_BAR; }
        if constexpr (!Epi::AFTER_DRAIN) { E(acc, cur, wr, wc, fr, fq); S.done(cur); }
        if (!has_next) break;
#pragma unroll
        for (int a = 0; a < 2; ++a)
#pragma unroll
            for (int b = 0; b < 2; ++b)
#pragma unroll
                for (int m = 0; m < 4; ++m)
#pragma unroll
                    for (int n = 0; n < 2; ++n) acc[a][b][m][n] = (f32x4){0.f, 0.f, 0.f, 0.f};
        cur = nxt; cA = nA; cB = nB; ++ui;
        if constexpr (ALIGN_EPI) { if (wr == 1) PG8_BAR; }
    }
    PG8_WAIT_V(0);
    if constexpr (!ALIGN_EPI) { if (wr == 0) PG8_BAR; }
    PG8_BAR;
    if constexpr (Epi::AFTER_DRAIN) { E.fused(acc, cur, wr, wc, fr, fq, lds, wid, lane); S.done(cur); }
#undef PG8_SA
#undef PG8_SB
#undef PG8_STAGE
#undef PG8_LDA
#undef PG8_LDB
#undef PG8_MMA
#undef PG8_WAIT_V
#undef PG8_WAIT_L
#undef PG8_BAR
#undef PG8_SCHED
}
}

using pg8::bf16_t; using pg8::bf16x8; using pg8::f32x4; using pg8::u32x4;
typedef short s16x4 __attribute__((ext_vector_type(4)));
typedef float f32x16 __attribute__((ext_vector_type(16)));
typedef unsigned u32x2 __attribute__((ext_vector_type(2)));
typedef float f32x2 __attribute__((ext_vector_type(2)));
#define LAS __attribute__((address_space(3)))
typedef LAS unsigned char lds_u8;

constexpr int NB = 2, T = 8192, DM = 1024, M = NB * T, PC = 4896, NPAD = 5120, DFF = 4096;
constexpr int C_QA = 0, C_KA = 512, C_VA = 1024, C_QB = 1536, C_KC = 2048, C_VC = 2176, C_KS = 2304, C_VS = 2432, C_KW = 2560, C_VW = 2688,
              C_GA = 2816, C_GB = 3840, C_F = 4864, C_G3 = 4872;
constexpr float LOG2E = 1.4426950408889634f, QSCALE = 0.125f * LOG2E, RMS_EPS = 1e-6f;
constexpr size_t MiB = 1u << 20;
constexpr size_t WS_KNT = 2 * MiB + 64 * 1024;
constexpr size_t WS_TOT = WS_KNT + 8192;
constexpr size_t WS_BAR = 2 * MiB + 512 * 1024;
constexpr size_t WS_PART = 0, WS_CUM = 1 * MiB, WS_KC = WS_CUM + 512 * 1024, WS_PB1 = 2 * MiB;
constexpr size_t WS_WIN = 3 * MiB, WS_WOF = 13 * MiB, WS_WON = 14 * MiB, WS_WOUT = 15 * MiB, WS_WUP = 17 * MiB, WS_WDN = 25 * MiB, WS_WC1 = 33 * MiB, WS_WC2 = 35 * MiB;
constexpr size_t WS_PROJ = 36 * MiB, WS_XB = 190 * MiB, WS_OA = 190 * MiB, WS_ON = 206 * MiB, WS_MIX = 222 * MiB;
constexpr int LDS_BYTES = 135168;
constexpr int REP_FOX = 1, REP_NSA = 1, REP_G1 = 1, REP_G5 = 1, REP_W = 1, REP_SEL = 1, REP_TOPK = 1, REP_CMP = 1, REP_G23 = 1;

struct Params { const float* in[16]; float* out; unsigned char* ws; };
typedef const __attribute__((address_space(4))) Params* KParams;

__device__ __forceinline__ unsigned pk2(float lo, float hi) {
    typedef float f2 __attribute__((ext_vector_type(2))); typedef __bf16 b2 __attribute__((ext_vector_type(2)));
    f2 v = {lo, hi}; b2 b = __builtin_convertvector(v, b2); return __builtin_bit_cast(unsigned, b);
}
__device__ __forceinline__ float bf2f(unsigned short h) { return __uint_as_float(((unsigned)h) << 16); }
__device__ __forceinline__ float bflo(unsigned w) { return __uint_as_float(w << 16); }
__device__ __forceinline__ float bfhi(unsigned w) { return __uint_as_float(w & 0xffff0000u); }
__device__ __forceinline__ float wave_sum(float v) {
#pragma unroll
    for (int o = 32; o >= 1; o >>= 1) v += __shfl_xor(v, o);
    return v;
}
__device__ __forceinline__ float sigmoidf_(float z) { return 1.0f / (1.0f + __expf(-z)); }
__device__ __forceinline__ float row_rstd(const float* part, int row) {
    const f32x4* p = (const f32x4*)(part + (size_t)row * 16);
    f32x4 a = p[0], b = p[1], c = p[2], d = p[3];
    float s = ((a[0] + a[1]) + (a[2] + a[3])) + ((b[0] + b[1]) + (b[2] + b[3])) + ((c[0] + c[1]) + (c[2] + c[3])) + ((d[0] + d[1]) + (d[2] + d[3]));
    return rsqrtf(s * (1.0f / 1024.0f) + RMS_EPS);
}
__device__ __forceinline__ int src_col(int n) {
    if (n < 1536) return n;
    if (n < 2816) return n + 8;
    if (n < 4864) return n + 32;
    if (n < 4872) return n - 4864 + 1536;
    return n - 4872 + 2824;
}
__device__ __forceinline__ void rope_cs(int pos, int i, float& cs, float& sn) {
    const float inv = exp2f(-(float)i * (18.931568569324174f / 8.0f));
    const float ang = (float)pos * inv;
    const float k = rintf(ang * 0.15915494309189535f);
    float r = fmaf(-k, 6.2831854820251465f, ang); r = fmaf(-k, -1.7484555e-7f, r);
    cs = __cosf(r); sn = __sinf(r);
}

__device__ __forceinline__ int vt_pos(int kv) { const int q = (kv >> 2) & 3; return (kv & ~12) | ((((q == 1) ? 2 : (q == 2) ? 1 : q)) << 2); }
template <int ACT  > struct EpiScaleBf16 {
    static constexpr bool PERM = true, AFTER_DRAIN = false; static constexpr int MID_T = -1;
    bf16_t* O; int ldc; int ncols; const float* part;
    __device__ __forceinline__ void operator()(const f32x4 (&acc)[2][2][4][2], const pg8::Unit& u, int wr, int wc, int fr, int fq) const {
#pragma unroll
        for (int ai = 0; ai < 2; ++ai)
#pragma unroll
            for (int m = 0; m < 4; ++m) {
                const int row = u.pm * 256 + ai * 128 + wr * 64 + m * 16 + fr;
                const float rs = row_rstd(part, row);
#pragma unroll
                for (int bj = 0; bj < 2; ++bj) {
                    const int colb = u.pn * 256 + bj * 128, col = colb + wc * 32 + 8 * fq;
                    if (col < ncols) {
                        f32x4 v0 = acc[ai][bj][m][0] * rs, v1 = acc[ai][bj][m][1] * rs;
                        if (ACT == 1) {
#pragma unroll
                            for (int e = 0; e < 4; ++e) { float a = fmaxf(v0[e], 0.f), b = fmaxf(v1[e], 0.f); v0[e] = a * a; v1[e] = b * b; }
                        }
                        u32x4 w; w.x = pk2(v0[0], v0[1]); w.y = pk2(v0[2], v0[3]); w.z = pk2(v1[0], v1[1]); w.w = pk2(v1[2], v1[3]);
                        const bool vt = (ACT == 0) && ((colb >= C_VA && colb < C_VA + 512) || colb == C_VS || colb == C_VW);
                        if (vt) {
                            unsigned short* tp = O + (size_t)((row & ~63) + (col & 63)) * ldc + (col & ~63) + vt_pos(row & 63);
                            tp[0] = (unsigned short)(w.x & 0xffffu); tp[(size_t)1 * ldc] = (unsigned short)(w.x >> 16); tp[(size_t)2 * ldc] = (unsigned short)(w.y & 0xffffu); tp[(size_t)3 * ldc] = (unsigned short)(w.y >> 16);
                            tp[(size_t)4 * ldc] = (unsigned short)(w.z & 0xffffu); tp[(size_t)5 * ldc] = (unsigned short)(w.z >> 16); tp[(size_t)6 * ldc] = (unsigned short)(w.w & 0xffffu); tp[(size_t)7 * ldc] = (unsigned short)(w.w >> 16);
                        } else *(u32x4*)(O + (size_t)row * ldc + col) = w;
                    }
                }
                if (m & 1) asm volatile("" ::: "memory");
            }
    }
};
template <bool FIRST> struct EpiGateMix {
    static constexpr bool PERM = false, AFTER_DRAIN = false; static constexpr int MID_T = -1;
    bf16_t* mix; const bf16_t* proj; int gcol0;
    __device__ __forceinline__ void operator()(const f32x4 (&acc)[2][2][4][2], const pg8::Unit& u, int wr, int wc, int fr, int fq) const {
#pragma unroll
        for (int ai = 0; ai < 2; ++ai)
#pragma unroll
            for (int m = 0; m < 4; ++m) {
                const int row = u.pm * 256 + ai * 128 + wr * 64 + m * 16 + fr;
#pragma unroll
                for (int bj = 0; bj < 2; ++bj)
#pragma unroll
                    for (int n = 0; n < 2; ++n) {
                        const int col = u.pn * 256 + bj * 128 + wc * 32 + 16 * n + 4 * fq;
                        const u32x2 g = *(const u32x2*)(proj + (size_t)row * PC + gcol0 + col);
                        const f32x4 a = acc[ai][bj][m][n];
                        float r0 = sigmoidf_(bflo(g.x)) * a[0], r1 = sigmoidf_(bfhi(g.x)) * a[1], r2 = sigmoidf_(bflo(g.y)) * a[2], r3 = sigmoidf_(bfhi(g.y)) * a[3];
                        bf16_t* mp = mix + (size_t)row * DM + col;
                        if (!FIRST) { const u32x2 o = *(const u32x2*)mp; r0 += bflo(o.x); r1 += bfhi(o.x); r2 += bflo(o.y); r3 += bfhi(o.y); }
                        u32x2 w; w.x = pk2(r0, r1); w.y = pk2(r2, r3); *(u32x2*)mp = w;
                    }
                asm volatile("" ::: "memory");
            }
    }
};
struct EpiGateFused {
    static constexpr bool PERM = false, AFTER_DRAIN = false; static constexpr int MID_T = 8;
    bf16_t* mix; const bf16_t* proj;
    __device__ __forceinline__ static float eneg(float g) { return fminf(__expf(-g), 1e30f); }
    __device__ __forceinline__ void mid(f32x4 (&acc)[2][2][4][2], const pg8::Unit& u, int wr, int wc, int fr, int fq) const {
#pragma unroll
        for (int ai = 0; ai < 2; ++ai)
#pragma unroll
            for (int m = 0; m < 4; ++m) {
                int row = u.pm * 256 + ai * 128 + wr * 64 + m * 16 + fr; asm volatile("" : "+v"(row));
#pragma unroll
                for (int bj = 0; bj < 2; ++bj)
#pragma unroll
                    for (int n = 0; n < 2; ++n) {
                        const int col = u.pn * 256 + bj * 128 + wc * 32 + 16 * n + 4 * fq;
                        const unsigned go = (unsigned)row * (unsigned)PC + (unsigned)col;
                        const u32x2 ga = *(const u32x2*)(proj + C_GA + go), gb = *(const u32x2*)(proj + C_GB + go);
                        f32x4 a = acc[ai][bj][m][n];
                        a[0] *= (1.0f + eneg(bflo(gb.x))) * __builtin_amdgcn_rcpf(1.0f + eneg(bflo(ga.x))); a[1] *= (1.0f + eneg(bfhi(gb.x))) * __builtin_amdgcn_rcpf(1.0f + eneg(bfhi(ga.x)));
                        a[2] *= (1.0f + eneg(bflo(gb.y))) * __builtin_amdgcn_rcpf(1.0f + eneg(bflo(ga.y))); a[3] *= (1.0f + eneg(bfhi(gb.y))) * __builtin_amdgcn_rcpf(1.0f + eneg(bfhi(ga.y)));
                        acc[ai][bj][m][n] = a;
                        asm volatile("" : "+v"(acc[ai][bj][m][n]) :: "memory");
                    }
            }
    }
    __device__ __forceinline__ void operator()(const f32x4 (&acc)[2][2][4][2], const pg8::Unit& u, int wr, int wc, int fr, int fq) const {
#pragma unroll
        for (int ai = 0; ai < 2; ++ai)
#pragma unroll
            for (int m = 0; m < 4; ++m) {
                int row = u.pm * 256 + ai * 128 + wr * 64 + m * 16 + fr; asm volatile("" : "+v"(row));
#pragma unroll
                for (int bj = 0; bj < 2; ++bj)
#pragma unroll
                    for (int n = 0; n < 2; ++n) {
                        const int col = u.pn * 256 + bj * 128 + wc * 32 + 16 * n + 4 * fq;
                        const u32x2 gb = *(const u32x2*)(proj + C_GB + (unsigned)row * (unsigned)PC + (unsigned)col);
                        const f32x4 a = acc[ai][bj][m][n];
                        const float r0 = a[0] * __builtin_amdgcn_rcpf(1.0f + eneg(bflo(gb.x))), r1 = a[1] * __builtin_amdgcn_rcpf(1.0f + eneg(bfhi(gb.x)));
                        const float r2 = a[2] * __builtin_amdgcn_rcpf(1.0f + eneg(bflo(gb.y))), r3 = a[3] * __builtin_amdgcn_rcpf(1.0f + eneg(bfhi(gb.y)));
                        u32x2 w; w.x = pk2(r0, r1); w.y = pk2(r2, r3); *(u32x2*)(mix + ((unsigned)row * (unsigned)DM + (unsigned)col)) = w;
                    }
                if (m & 1) asm volatile("" ::: "memory");
            }
    }
};
struct EpiResidual {
    static constexpr bool PERM = false, AFTER_DRAIN = false; static constexpr int MID_T = -1;
    const float* xi; float* xo; bf16_t* xb; float* part; bool wxb;
    __device__ __forceinline__ void operator()(const f32x4 (&acc)[2][2][4][2], const pg8::Unit& u, int wr, int wc, int fr, int fq) const {
#pragma unroll
        for (int ai = 0; ai < 2; ++ai)
#pragma unroll
            for (int m = 0; m < 4; ++m) {
                const int row = u.pm * 256 + ai * 128 + wr * 64 + m * 16 + fr;
                float ss = 0.f;
#pragma unroll
                for (int bj = 0; bj < 2; ++bj)
#pragma unroll
                    for (int n = 0; n < 2; ++n) {
                        const int col = u.pn * 256 + bj * 128 + wc * 32 + 16 * n + 4 * fq;
                        const size_t off = (size_t)row * DM + col;
                        f32x4 v = *(const f32x4*)(xi + off) + acc[ai][bj][m][n];
                        *(f32x4*)(xo + off) = v;
                        if (wxb) { u32x2 w; w.x = pk2(v[0], v[1]); w.y = pk2(v[2], v[3]); *(u32x2*)(xb + off) = w; }
                        ss += (v[0] * v[0] + v[1] * v[1]) + (v[2] * v[2] + v[3] * v[3]);
                    }
                ss += __shfl_xor(ss, 16); ss += __shfl_xor(ss, 32);
                if (fq == 0) part[(size_t)row * 16 + u.pn * 4 + wc] = ss;
                asm volatile("" ::: "memory");
            }
    }
};

struct WTile { const float* W; bf16_t* WT; const float* rs; int K, Nsrc, Ndst, ldk, koff, mode, kt, nt; };
constexpr int W_NTILES = 1032;
__device__ __forceinline__ WTile wtile_decode(KParams P, int layer, int g) {
    unsigned char* ws = P->ws;
    WTile t; int base;
    if (g < 320)       { base = 0;    t.W = P->in[2] + (size_t)layer * DM * PC;   t.WT = (bf16_t*)(ws + WS_WIN);  t.rs = P->in[1] + layer * DM;  t.K = DM;   t.Nsrc = PC;  t.Ndst = PC;  t.ldk = DM;   t.koff = 0;   t.mode = 1; }
    else if (g < 576)  { base = 320;  t.W = P->in[13] + (size_t)layer * DM * DFF; t.WT = (bf16_t*)(ws + WS_WUP);  t.rs = P->in[12] + layer * DM; t.K = DM;   t.Nsrc = DFF; t.Ndst = DFF; t.ldk = DM;   t.koff = 0;   t.mode = 0; }
    else if (g < 832)  { base = 576;  t.W = P->in[14] + (size_t)layer * DFF * DM; t.WT = (bf16_t*)(ws + WS_WDN);  t.rs = nullptr;                t.K = DFF;  t.Nsrc = DM;  t.Ndst = DM;  t.ldk = DFF;  t.koff = 0;   t.mode = 0; }
    else if (g < 896)  { base = 832;  t.W = P->in[11] + (size_t)layer * DM * DM;  t.WT = (bf16_t*)(ws + WS_WOUT); t.rs = nullptr;                t.K = DM;   t.Nsrc = DM;  t.Ndst = DM;  t.ldk = DM;   t.koff = 0;   t.mode = 0; }
    else if (g < 928)  { base = 896;  t.W = P->in[9] + (size_t)layer * 512 * DM;  t.WT = (bf16_t*)(ws + WS_WOF);  t.rs = nullptr;                t.K = 512;  t.Nsrc = DM;  t.Ndst = DM;  t.ldk = 1024; t.koff = 0;   t.mode = 0; }
    else if (g < 960)  { base = 928;  t.W = P->in[10] + (size_t)layer * 512 * DM; t.WT = (bf16_t*)(ws + WS_WOF);  t.rs = nullptr;                t.K = 512;  t.Nsrc = DM;  t.Ndst = DM;  t.ldk = 1024; t.koff = 512; t.mode = 0; }
    else if (g < 1024) { const int kv = (g - 960) >> 5; base = 960 + 32 * kv;  t.W = P->in[5] + (size_t)(layer * 2 + kv) * 2048 * 256; t.WT = (bf16_t*)(ws + WS_WC1) + (size_t)kv * 256 * 2048; t.rs = nullptr; t.K = 2048; t.Nsrc = 256; t.Ndst = 256; t.ldk = 2048; t.koff = 0; t.mode = 0; }
    else               { const int kv = (g - 1024) >> 2; base = 1024 + 4 * kv; t.W = P->in[7] + (size_t)(layer * 2 + kv) * 256 * 64;   t.WT = (bf16_t*)(ws + WS_WC2) + (size_t)kv * 64 * 256;   t.rs = nullptr; t.K = 256;  t.Nsrc = 64;  t.Ndst = 64;  t.ldk = 256;  t.koff = 0; t.mode = 0; }
    const int tl = g - base, nkt = t.K >> 6;
    t.kt = tl % nkt; t.nt = tl / nkt;
    return t;
}
__device__ __forceinline__ void wtile_issue(const WTile& t, int tid, f32x4 (&v)[8], float (&rs)[8]) {
    const int c4 = tid & 63, r0 = tid >> 6, nd = t.nt * 256 + 4 * c4;
    const bool ok = nd < t.Ndst;
    const int ns = t.mode ? src_col(nd) : nd;
#pragma unroll
    for (int i = 0; i < 8; ++i) {
        const int k = t.kt * 64 + r0 + 8 * i;
        v[i] = ok ? *(const f32x4*)(t.W + (size_t)k * t.Nsrc + ns) : (f32x4){0.f, 0.f, 0.f, 0.f};
        rs[i] = t.rs ? t.rs[k] : 1.0f;
    }
}
__device__ __forceinline__ void wtile_finish(const WTile& t, int tid, lds_u8* sm, const f32x4 (&v)[8], const float (&rs)[8]) {
    LAS float* sT = (LAS float*)sm;
    const int c4 = tid & 63, r0 = tid >> 6, nd = t.nt * 256 + 4 * c4;
    const float cs = (t.mode && (nd < 512 || (nd >= 1536 && nd < 2048))) ? QSCALE : 1.0f;
#pragma unroll
    for (int i = 0; i < 8; ++i) *(LAS f32x4*)(sT + (r0 + 8 * i) * 260 + 4 * (c4 ^ i)) = v[i] * (rs[i] * cs);
    __syncthreads();
#pragma unroll
    for (int j = 0; j < 4; ++j) {
        const int p = tid + 512 * j, nl = p >> 3, c = p & 7, n2 = t.nt * 256 + nl;
        const LAS float* q = sT + (8 * c) * 260 + 4 * ((nl >> 2) ^ c) + (nl & 3);
        u32x4 w; w.x = pk2(q[0], q[260]); w.y = pk2(q[2 * 260], q[3 * 260]); w.z = pk2(q[4 * 260], q[5 * 260]); w.w = pk2(q[6 * 260], q[7 * 260]);
        if (n2 < t.Ndst) *(u32x4*)(t.WT + (size_t)n2 * t.ldk + t.koff + t.kt * 64 + 8 * c) = w;
    }
    __syncthreads();
}

__device__ __forceinline__ void phase_weights(KParams P, int layer, lds_u8* sm, int G, int bid, int tid) {
    unsigned char* ws = P->ws;
    {
        f32x4 va[8], vb[8]; float ra[8], rb[8];
        int g0 = bid;
        if (g0 < W_NTILES) {
            WTile t0 = wtile_decode(P, layer, g0);
            wtile_issue(t0, tid, va, ra);
            for (;;) {
                const int g1 = g0 + G; const bool has1 = g1 < W_NTILES;
                WTile t1 = wtile_decode(P, layer, has1 ? g1 : g0);
                if (has1) wtile_issue(t1, tid, vb, rb);
                wtile_finish(t0, tid, sm, va, ra);
                if (!has1) break;
                g0 = g1 + G; const bool has0 = g0 < W_NTILES;
                t0 = wtile_decode(P, layer, has0 ? g0 : g1);
                if (has0) wtile_issue(t0, tid, va, ra);
                wtile_finish(t1, tid, sm, vb, rb);
                if (!has0) break;
            }
        }
    }
    for (int wb = G - 1 - bid; wb < 32; wb += G) {
        const int kv = wb >> 4, ch = wb & 15, j = tid & 255, kh = tid >> 8;
        const float* w1 = P->in[5] + (size_t)(layer * 2 + kv) * 2048 * 256;
        const float* pos = P->in[4] + (size_t)(layer * 2 + kv) * 2048;
        float a = 0.f;
        {
            const int kb = ch * 128 + kh * 64;
#pragma unroll 1
            for (int k0 = 0; k0 < 64; k0 += 16) {
                float wv[16], pv[16];
#pragma unroll
                for (int i = 0; i < 16; ++i) { wv[i] = w1[(size_t)(kb + k0 + i) * 256 + j]; pv[i] = pos[kb + k0 + i]; }
#pragma unroll
                for (int i = 0; i < 16; ++i) a += pv[i] * wv[i];
            }
        }
        LAS float* red = (LAS float*)sm;
        if (kh == 1) red[j] = a;
        __syncthreads();
        if (kh == 0) ((float*)(ws + WS_PB1))[(kv * 16 + ch) * 256 + j] = a + red[j];
        __syncthreads();
    }
}

__device__ __forceinline__ void phase_x_to_bf16(KParams P, int G, int bid, int wid, int lane) {
    const float* __restrict__ x = P->in[0]; bf16_t* __restrict__ XB = (bf16_t*)(P->ws + WS_XB); float* __restrict__ part = (float*)(P->ws + WS_PART);
    for (int row0 = bid * 8 + wid; row0 < M; row0 += 4 * G * 8) {
        f32x4 v[4][4];
#pragma unroll
        for (int k = 0; k < 4; ++k) {
            const int row = row0 + k * G * 8;
#pragma unroll
            for (int i = 0; i < 4; ++i) v[k][i] = (row < M) ? ((const f32x4*)(x + (size_t)row * DM))[lane + 64 * i] : (f32x4){0.f, 0.f, 0.f, 0.f};
        }
#pragma unroll
        for (int k = 0; k < 4; ++k) {
            const int row = row0 + k * G * 8;
            if (row < M) {
                float ss = 0.f;
#pragma unroll
                for (int i = 0; i < 4; ++i) {
                    const f32x4 t = v[k][i];
                    ss += (t[0] * t[0] + t[1] * t[1]) + (t[2] * t[2] + t[3] * t[3]);
                    u32x2 w; w.x = pk2(t[0], t[1]); w.y = pk2(t[2], t[3]);
                    *(u32x2*)(XB + (size_t)row * DM + 4 * (lane + 64 * i)) = w;
                }
                ss = wave_sum(ss);
                if (lane < 16) part[(size_t)row * 16 + lane] = (lane == 0) ? ss : 0.f;
            }
        }
    }
}

__device__ __forceinline__ void phase_prep(KParams P, int layer, lds_u8* sm, int G, int bid, int tid, int wid, int lane) {
    unsigned char* ws = P->ws;
    bf16_t* proj = (bf16_t*)(ws + WS_PROJ);
    for (int w = bid; w < 256; w += G) {
        const int bh = w >> 4, c = w & 15, b = bh >> 3, h = bh & 7, t = c * 512 + tid;
        const float z = bf2f(proj[(size_t)(b * T + t) * PC + C_F + h]) + P->in[3][layer * 8 + h];
        const float lf = fminf(z, 0.f) - log1pf(__expf(-fabsf(z)));
        LAS float* sc = (LAS float*)sm;
        sc[tid] = lf;
        __syncthreads();
        for (int o = 1; o < 512; o <<= 1) {
            float v = sc[tid]; if (tid >= o) v += sc[tid - o];
            __syncthreads(); sc[tid] = v; __syncthreads();
        }
        const float pfx = sc[tid] * LOG2E;
        ((float*)(ws + WS_CUM))[(size_t)bh * T + t] = pfx;
        if (tid == 511) ((float*)(ws + WS_TOT))[bh * 16 + c] = pfx;
        __syncthreads();
    }
    for (int item = bid * 8 + wid; item < 16 * 128; item += G * 8) {
        const int bh = item >> 7, jt = item & 127, b = bh >> 3, h = bh & 7;
        const u32x4* kp = (const u32x4*)(proj + (size_t)(b * T + 64 * jt + lane) * PC + C_KA + h * 64);
        float ss = 0.f;
#pragma unroll
        for (int c = 0; c < 8; ++c) { const u32x4 w = kp[c];
#pragma unroll
            for (int e = 0; e < 4; ++e) { const float lo = bflo(w[e]), hi2 = bfhi(w[e]); ss += lo * lo + hi2 * hi2; } }
#pragma unroll
        for (int o = 32; o >= 1; o >>= 1) ss = fmaxf(ss, __shfl_xor(ss, o));
        if (lane == 0) ((float*)(ws + WS_KNT))[item] = sqrtf(ss) * 1.0001f;
    }
    for (int idx = bid * 512 + tid; idx < M * 12; idx += G * 512) {
        const int row = idx / 12, hh = idx - row * 12, pos = row & (T - 1);
        const int col = hh < 8 ? C_QB + hh * 64 : (hh < 10 ? C_KS + (hh - 8) * 64 : C_KW + (hh - 10) * 64);
        u32x4* p = (u32x4*)(proj + (size_t)row * PC + col);
        const u32x4 a = p[0], b = p[1];
        u32x4 oa, ob;
#pragma unroll
        for (int w = 0; w < 4; ++w) {
            float cs0, sn0, cs1, sn1; rope_cs(pos, 2 * w, cs0, sn0); rope_cs(pos, 2 * w + 1, cs1, sn1);
            const float x10 = bflo(a[w]), x11 = bfhi(a[w]), x20 = bflo(b[w]), x21 = bfhi(b[w]);
            oa[w] = pk2(x10 * cs0 - x20 * sn0, x11 * cs1 - x21 * sn1);
            ob[w] = pk2(x20 * cs0 + x10 * sn0, x21 * cs1 + x11 * sn1);
        }
        p[0] = oa; p[1] = ob;
    }
    for (int u = bid; u < 256; u += G) {
        const int kv = u >> 7, bg = (u >> 5) & 3, rt = u & 31, b = bg >> 1, g = bg & 1;
        const int col0 = (kv ? C_VC : C_KC) + g * 64, fr = lane & 15, kq = lane >> 4;
        int nld = rt * 16 + fr; if (nld > 510) nld = 510;
        const bf16_t* Ab = proj + (size_t)(b * T + 16 * nld) * PC + col0;
        const bf16_t* Bb = (const bf16_t*)(ws + WS_WC1) + (size_t)kv * 256 * 2048 + (size_t)fr * 2048;
        f32x4 acc[16];
#pragma unroll
        for (int j = 0; j < 16; ++j) acc[j] = (f32x4){0.f, 0.f, 0.f, 0.f};
#pragma unroll 2
        for (int ks = 0; ks < 8; ++ks) {
            const int k0 = 256 * wid + 32 * ks, l = k0 >> 6, d0 = (k0 & 63) + 8 * kq;
            const bf16x8 a = *(const bf16x8*)(Ab + (size_t)l * PC + d0);
#pragma unroll
            for (int jt = 0; jt < 16; ++jt) {
                const bf16x8 bb = *(const bf16x8*)(Bb + (size_t)jt * 16 * 2048 + k0 + 8 * kq);
                acc[jt] = __builtin_amdgcn_mfma_f32_16x16x32_bf16(a, bb, acc[jt], 0, 0, 0);
            }
        }
        LAS float* red = (LAS float*)sm;
#pragma unroll 1
        for (int w = 0; w < 8; ++w) {
            if (wid == w) {
#pragma unroll
                for (int jt = 0; jt < 16; ++jt)
#pragma unroll
                    for (int r = 0; r < 4; ++r) { const int ix = (4 * kq + r) * 256 + 16 * jt + fr; if (w == 0) red[ix] = acc[jt][r]; else red[ix] += acc[jt][r]; }
            }
            __syncthreads();
        }
        LAS bf16_t* hid = (LAS bf16_t*)(sm + 16384);
        LAS float* outb = (LAS float*)(sm + 16384 + 8448);
        {
            const int j = tid & 255;
            const float* pb1 = (const float*)(ws + WS_PB1) + kv * 16 * 256 + j;
            float bias = P->in[6][(layer * 2 + kv) * 256 + j];
#pragma unroll
            for (int c = 0; c < 16; ++c) bias += pb1[c * 256];
#pragma unroll
            for (int i = 0; i < 8; ++i) {
                const int e = tid + 512 * i, row = e >> 8;
                const float x = red[e] + bias;
                const float uu = 0.7978845608028654f * (x + 0.044715f * x * x * x);
                const float th = 1.0f - 2.0f / (__expf(2.0f * uu) + 1.0f);
                const float gl = 0.5f * x * (1.0f + th);
                hid[row * 264 + j] = (bf16_t)(pk2(gl, 0.f) & 0xffffu);
            }
        }
        __syncthreads();
        if (wid < 4) {
            f32x4 a2 = (f32x4){0.f, 0.f, 0.f, 0.f};
            const bf16_t* B2 = (const bf16_t*)(ws + WS_WC2) + (size_t)kv * 64 * 256 + (size_t)(16 * wid + fr) * 256;
#pragma unroll
            for (int ks = 0; ks < 8; ++ks) {
                const bf16x8 a = *(const LAS bf16x8*)(hid + fr * 264 + 32 * ks + 8 * kq);
                const bf16x8 bb = *(const bf16x8*)(B2 + 32 * ks + 8 * kq);
                a2 = __builtin_amdgcn_mfma_f32_16x16x32_bf16(a, bb, a2, 0, 0, 0);
            }
            const float b2 = P->in[8][(layer * 2 + kv) * 64 + 16 * wid + fr];
#pragma unroll
            for (int r = 0; r < 4; ++r) outb[(4 * kq + r) * 64 + 16 * wid + fr] = a2[r] + b2;
        }
        __syncthreads();
        bf16_t* KCV = (bf16_t*)(ws + WS_KC) + (size_t)(kv * 4 + bg) * 512 * 64;
#pragma unroll
        for (int i = 0; i < 2; ++i) {
            const int e = tid + 512 * i, row = e >> 6, c = e & 63, n = rt * 16 + row;
            float v = outb[e];
            if (kv == 0 && c < 16) {
                const int i8 = c & 7; const float x1 = outb[row * 64 + i8], x2 = outb[row * 64 + 8 + i8];
                float cs, sn; rope_cs(16 * n + 31, i8, cs, sn);
                v = c < 8 ? x1 * cs - x2 * sn : x2 * cs + x1 * sn;
            }
            if (n >= 511) v = 0.f;
            if (kv == 0) KCV[(size_t)n * 64 + c] = (bf16_t)(pk2(v, 0.f) & 0xffffu);
            else KCV[(size_t)(n >> 6) * 4096 + c * 64 + vt_pos(n & 63)] = (bf16_t)(pk2(v, 0.f) & 0xffffu);
        }
        __syncthreads();
    }
}

constexpr int A_STAGE = 18688  , A_IMP = 3 * A_STAGE, A_OPART = A_IMP  , A_SELM = A_IMP + 65536, A_TL = A_SELM + 1024, A_END = A_TL + 528;
static_assert(A_END + 64 <= 131072 && 64 * 129 * 4 <= 65536, "attention LDS map");
struct FS { f32x16 o0, o1; float m, l; };
__device__ __forceinline__ void fs_init(FS& s) {
#pragma unroll
    for (int r = 0; r < 16; ++r) { s.o0[r] = 0.f; s.o1[r] = 0.f; }
    s.m = -1e30f; s.l = 0.f;
}
struct MaskCtx { int qpos; int diag0; int cur; unsigned mw0, mw1, mw2, mw3; };

__device__ __forceinline__ float xhalf_max(float v) { auto rr = __builtin_amdgcn_permlane32_swap(__float_as_uint(v), __float_as_uint(v), false, false); return fmaxf(__uint_as_float(rr[0]), __uint_as_float(rr[1])); }
__device__ __forceinline__ float xhalf_sum(float v) { auto rr = __builtin_amdgcn_permlane32_swap(__float_as_uint(v), __float_as_uint(v), false, false); return __uint_as_float(rr[0]) + __uint_as_float(rr[1]); }

#define LDS_BARRIER() asm volatile("s_waitcnt lgkmcnt(0)\n\ts_barrier" ::: "memory")
__device__ __forceinline__ float quad_sum(float v) {
    v += __uint_as_float((unsigned)__builtin_amdgcn_update_dpp(0, (int)__float_as_uint(v), 0xB1, 0xF, 0xF, false));
    v += __uint_as_float((unsigned)__builtin_amdgcn_update_dpp(0, (int)__float_as_uint(v), 0x4E, 0xF, 0xF, false));
    return v;
}
__device__ __forceinline__ int oct_sum(int v) {
    v += __builtin_amdgcn_update_dpp(0, v, 0xB1, 0xF, 0xF, false);
    v += __builtin_amdgcn_update_dpp(0, v, 0x4E, 0xF, 0xF, false);
    v += __builtin_amdgcn_update_dpp(0, v, 0x141, 0xF, 0xF, false);
    return v;
}
template <int MODE, int PASS>
__device__ __forceinline__ void flash_run(lds_u8* sm, const bf16_t* __restrict__ Kg, const bf16_t* __restrict__ Vg, int pitch, int first, int nt, bool uselist, const LAS int* list,
                                          const float* __restrict__ cum, float cref, const bf16x8 (&qf)[4], FS& st, const MaskCtx& mc, int tid, int lane, int qloc) {
    if (nt <= 0) return;
    const int r32 = lane & 31, hi = lane >> 5;
    const int krow = tid >> 3, kch = tid & 7;
    u32x4 rkA, rvA, rkB, rvB; float rcA = 0.f, rcB = 0.f;
    float invl = 0.f;
    if (PASS == 2) invl = st.l > 0.f ? 1.0f / st.l : 0.f;
    auto tile_of = [&](int i) -> int { return uselist ? list[i] : first + i; };
    auto gload = [&](int jt, u32x4& rk, u32x4& rv, float& rc) {
        rk = *(const u32x4*)(Kg + (size_t)(64 * jt + krow) * pitch + kch * 8);
        if (PASS != 1) rv = *(const u32x4*)(Vg + (size_t)(64 * jt + krow) * pitch + kch * 8);
        if (MODE == 0) { if (tid < 64) rc = cref - (cum[64 * jt + tid] + ((const LAS float*)(sm + A_SELM))[16 + (jt >> 3)]); }
    };
    auto lstore = [&](int buf, const u32x4& rk, const u32x4& rv, float rc) {
        lds_u8* bb = sm + buf * A_STAGE;
        *(LAS u32x4*)(bb + krow * 144 + kch * 16) = rk;
        if (PASS != 1) *(LAS u32x4*)(bb + 9216 + krow * 144 + kch * 16) = rv;
        if (MODE == 0) {
            if (tid < 64) {
                const unsigned hb = pk2(rc, 0.f) & 0xffffu; const float lo = rc - bflo(hb);
                *(LAS u32x4*)(bb + tid * 144 + 128) = (u32x4){hb | (pk2(lo, 0.f) << 16), 0u, 0u, 0u};
            }
        }
    };
    f32x16 negm;
#pragma unroll
    for (int r = 0; r < 16; ++r) negm[r] = (PASS == 2) ? -st.m : 0.f;
    if (PASS != 2) st.m = 0.f;
    auto smm = [&](int buf, f32x16& d0, f32x16& d1) {
        const lds_u8* Ks = sm + buf * A_STAGE;
        bf16x8 kf[8];
#pragma unroll
        for (int s = 0; s < 4; ++s) {
            kf[2 * s]     = *(const LAS bf16x8*)(Ks + r32 * 144 + (16 * s + 8 * hi) * 2);
            kf[2 * s + 1] = *(const LAS bf16x8*)(Ks + (r32 + 32) * 144 + (16 * s + 8 * hi) * 2);
        }
        __builtin_amdgcn_sched_barrier(0);
        d0 = __builtin_amdgcn_mfma_f32_32x32x16_bf16(kf[0], qf[0], negm, 0, 0, 0); d1 = __builtin_amdgcn_mfma_f32_32x32x16_bf16(kf[1], qf[0], negm, 0, 0, 0);
#pragma unroll
        for (int s = 1; s < 4; ++s) { d0 = __builtin_amdgcn_mfma_f32_32x32x16_bf16(kf[2 * s], qf[s], d0, 0, 0, 0); d1 = __builtin_amdgcn_mfma_f32_32x32x16_bf16(kf[2 * s + 1], qf[s], d1, 0, 0, 0); }
        if (MODE == 0) {
            const bf16x8 b0 = *(const LAS bf16x8*)(Ks + r32 * 144 + 128 + 16 * hi), b1 = *(const LAS bf16x8*)(Ks + (r32 + 32) * 144 + 128 + 16 * hi);
            const short one = hi ? (short)0 : (short)0x3F80;
            const bf16x8 qb1 = (bf16x8){one, one, 0, 0, 0, 0, 0, 0};
            d0 = __builtin_amdgcn_mfma_f32_32x32x16_bf16(b0, qb1, d0, 0, 0, 0); d1 = __builtin_amdgcn_mfma_f32_32x32x16_bf16(b1, qb1, d1, 0, 0, 0);
        }
        __builtin_amdgcn_sched_barrier(0);
    };
    auto softpv = [&](int jt, int buf, f32x16& p0, f32x16& p1, f32x16& pn0, f32x16& pn1, bool has_next) {
        const lds_u8* Vt = sm + buf * A_STAGE + 9216;
        const LAS float* cb = (const LAS float*)(sm + buf * A_STAGE + 18432);
        const float NEG = -INFINITY;
        bool selbit = true;
        if (MODE == 2) { const unsigned w = ((const LAS unsigned*)(sm + A_SELM))[qloc * 4 + (jt >> 5)]; selbit = (w >> (jt & 31)) & 1u; }
        bool need = false;
        if (MODE == 0) need = jt >= mc.diag0;
        if (MODE == 1) need = 16 * (64 * jt + 63) + 31 > mc.diag0;
        if (MODE == 2) need = jt == mc.cur;
        if (MODE == 3) need = (jt == mc.cur) || (jt + 8 == mc.cur);
        if (need) {
#pragma unroll
            for (int r = 0; r < 16; ++r) {
                const int kl = (r & 3) + 8 * (r >> 2) + 4 * hi, k0 = 64 * jt + kl, k1 = k0 + 32;
                float s0 = p0[r], s1 = p1[r];
                if (MODE == 0 || MODE == 2) { if (k0 > mc.qpos) s0 = NEG; if (k1 > mc.qpos) s1 = NEG; }
                if (MODE == 1) { if (16 * k0 + 31 > mc.qpos) s0 = NEG; if (16 * k1 + 31 > mc.qpos) s1 = NEG; }
                if (MODE == 3) { if (k0 > mc.qpos || mc.qpos - k0 >= 512) s0 = NEG; if (k1 > mc.qpos || mc.qpos - k1 >= 512) s1 = NEG; }
                p0[r] = s0; p1[r] = s1;
            }
        }
        if (PASS != 2) {
            float m0 = __builtin_fmaxf(__builtin_fmaxf(p0[0], p0[1]), p0[2]), m1 = __builtin_fmaxf(__builtin_fmaxf(p1[0], p1[1]), p1[2]);
#pragma unroll
            for (int r = 3; r < 15; r += 2) { m0 = __builtin_fmaxf(__builtin_fmaxf(m0, p0[r]), p0[r + 1]); m1 = __builtin_fmaxf(__builtin_fmaxf(m1, p1[r]), p1[r + 1]); }
            float mx = __builtin_fmaxf(__builtin_fmaxf(m0, m1), __builtin_fmaxf(p0[15], p1[15]));
            mx = xhalf_max(mx);
            if (MODE == 2) mx = selbit ? mx : NEG;
            if (__any(mx > 8.0f)) {
                const float d = fmaxf(mx, 0.f), al = __builtin_amdgcn_exp2f(-d);
                st.m += d; st.l *= al;
#pragma unroll
                for (int r = 0; r < 16; ++r) { p0[r] -= d; p1[r] -= d; negm[r] -= d; }
                if (has_next) {
#pragma unroll
                    for (int r = 0; r < 16; ++r) { pn0[r] -= d; pn1[r] -= d; }
                }
                if (PASS == 0) {
#pragma unroll
                    for (int r = 0; r < 16; ++r) { st.o0[r] *= al; st.o1[r] *= al; }
                }
            }
            f32x2 acc2 = {0.f, 0.f};
#pragma unroll
            for (int r = 0; r < 16; r += 2) {
                p0[r] = __builtin_amdgcn_exp2f(p0[r]); p0[r + 1] = __builtin_amdgcn_exp2f(p0[r + 1]); p1[r] = __builtin_amdgcn_exp2f(p1[r]); p1[r + 1] = __builtin_amdgcn_exp2f(p1[r + 1]);
                acc2 += (f32x2){p0[r], p0[r + 1]}; acc2 += (f32x2){p1[r], p1[r + 1]};
            }
            float sum = xhalf_sum(acc2.x + acc2.y);
            if (MODE == 2) sum = selbit ? sum : 0.f;
            st.l += sum;
        } else {
#pragma unroll
            for (int r = 0; r < 16; ++r) { p0[r] = __builtin_amdgcn_exp2f(p0[r]) * invl; p1[r] = __builtin_amdgcn_exp2f(p1[r]) * invl; }
            float A[8], H[8];
#pragma unroll
            for (int g8 = 0; g8 < 8; ++g8) {
                const int hf = g8 >> 2, u4 = g8 & 3;
                const float x0 = hf ? p1[4 * u4] : p0[4 * u4], x1 = hf ? p1[4 * u4 + 1] : p0[4 * u4 + 1], x2 = hf ? p1[4 * u4 + 2] : p0[4 * u4 + 2], x3 = hf ? p1[4 * u4 + 3] : p0[4 * u4 + 3];
                A[g8] = quad_sum((x0 + x1) + (x2 + 0.5f * x3)); H[g8] = quad_sum(0.5f * x3);
            }
            float W[17];
#pragma unroll
            for (int g8 = 0; g8 < 8; ++g8) {
                const auto ra = __builtin_amdgcn_permlane32_swap(__float_as_uint(A[g8]), __float_as_uint(A[g8]), false, false);
                const auto rh = __builtin_amdgcn_permlane32_swap(__float_as_uint(H[g8]), __float_as_uint(H[g8]), false, false);
                const float a0 = __uint_as_float(ra[0]), a1 = __uint_as_float(ra[1]), h0 = __uint_as_float(rh[0]), h1 = __uint_as_float(rh[1]);
                if (g8 == 0) W[0] = a0; else W[2 * g8] += a0;
                W[2 * g8 + 1] = h0 + a1; W[2 * g8 + 2] = h1;
            }
            if ((lane & 35) == 0) {
                LAS float* imp = (LAS float*)(sm + A_IMP) + qloc * 129 + 16 * jt;
#pragma unroll
                for (int k = 0; k < 17; ++k) imp[k] += W[k];
            }
        }
        if (PASS != 1) {
            const unsigned pmask = (MODE == 2) ? (selbit ? 0xffffffffu : 0u) : 0xffffffffu;
            bf16x8 pb[4];
#pragma unroll
            for (int sp = 0; sp < 4; ++sp) {
                const int rb = (sp & 1) * 8;
                u32x4 pw;
                if (sp < 2) { pw.x = pk2(p0[rb], p0[rb + 1]); pw.y = pk2(p0[rb + 2], p0[rb + 3]); pw.z = pk2(p0[rb + 4], p0[rb + 5]); pw.w = pk2(p0[rb + 6], p0[rb + 7]); }
                else        { pw.x = pk2(p1[rb], p1[rb + 1]); pw.y = pk2(p1[rb + 2], p1[rb + 3]); pw.z = pk2(p1[rb + 4], p1[rb + 5]); pw.w = pk2(p1[rb + 6], p1[rb + 7]); }
                if (MODE == 2) { pw.x &= pmask; pw.y &= pmask; pw.z &= pmask; pw.w &= pmask; }
                pb[sp] = __builtin_bit_cast(bf16x8, pw);
            }
#pragma unroll
            for (int dh = 0; dh < 2; ++dh) {
                bf16x8 vf[4];
#pragma unroll
                for (int sp = 0; sp < 4; ++sp) {
                    const int kvb = (sp & 1) * 16 + (sp >> 1) * 32;
                    vf[sp] = *(const LAS bf16x8*)(Vt + (r32 + 32 * dh) * 144 + (kvb + 8 * hi) * 2);
                }
                __builtin_amdgcn_sched_barrier(0);
#pragma unroll
                for (int sp = 0; sp < 4; ++sp) {
                    if (dh == 0) st.o0 = __builtin_amdgcn_mfma_f32_32x32x16_bf16(vf[sp], pb[sp], st.o0, 0, 0, 0);
                    else         st.o1 = __builtin_amdgcn_mfma_f32_32x32x16_bf16(vf[sp], pb[sp], st.o1, 0, 0, 0);
                }
                __builtin_amdgcn_sched_barrier(0);
            }
        }
    };
    gload(tile_of(0), rkA, rvA, rcA);
    if (nt > 1) gload(tile_of(1), rkB, rvB, rcB);
    lstore(0, rkA, rvA, rcA);
    if (nt > 1) lstore(1, rkB, rvB, rcB);
    if (nt > 2) gload(tile_of(2), rkA, rvA, rcA);
    LDS_BARRIER();
    auto wave_active = [&](int jt) -> bool {
        if (MODE != 2) return true;
        const unsigned w = ((const LAS unsigned*)(sm + A_SELM))[qloc * 4 + (jt >> 5)];
        return __any((w >> (jt & 31)) & 1u) != 0;
    };
    f32x16 pa0, pa1;
    int b0 = 0;
    for (int i = 0; i < nt; i += 2) {
        int b1 = b0 + 1; if (b1 == 3) b1 = 0; int b2 = b1 + 1; if (b2 == 3) b2 = 0;
        if (i + 3 < nt) gload(tile_of(i + 3), rkB, rvB, rcB);
        if (wave_active(tile_of(i))) { smm(b0, pa0, pa1); softpv(tile_of(i), b0, pa0, pa1, pa0, pa1, false); }
        if (i + 2 < nt) lstore(b2, rkA, rvA, rcA);
        LDS_BARRIER();
        if (i + 1 >= nt) break;
        if (i + 4 < nt) gload(tile_of(i + 4), rkA, rvA, rcA);
        if (wave_active(tile_of(i + 1))) { smm(b1, pa0, pa1); softpv(tile_of(i + 1), b1, pa0, pa1, pa0, pa1, false); }
        if (i + 3 < nt) lstore(b0, rkB, rvB, rcB);
        LDS_BARRIER();
        b0 = b2;
    }
}

__device__ __forceinline__ void load_q(bf16x8 (&qf)[4], const bf16_t* qrow, int hi) {
#pragma unroll
    for (int s = 0; s < 4; ++s) qf[s] = *(const bf16x8*)(qrow + 16 * s + 8 * hi);
}
__device__ __forceinline__ void store_o(bf16_t* orow, const f32x16& v0, const f32x16& v1, int hi) {
#pragma unroll
    for (int g4 = 0; g4 < 4; ++g4) {
        u32x2 a, b; a.x = pk2(v0[4 * g4], v0[4 * g4 + 1]); a.y = pk2(v0[4 * g4 + 2], v0[4 * g4 + 3]); b.x = pk2(v1[4 * g4], v1[4 * g4 + 1]); b.y = pk2(v1[4 * g4 + 2], v1[4 * g4 + 3]);
        *(u32x2*)(orow + 8 * g4 + 4 * hi) = a; *(u32x2*)(orow + 32 + 8 * g4 + 4 * hi) = b;
    }
}

__device__ __forceinline__ void oacc_store(float* orow, const f32x16& v0, const f32x16& v1, int hi) {
#pragma unroll
    for (int g4 = 0; g4 < 4; ++g4) {
        *(f32x4*)(orow + 8 * g4 + 4 * hi) = (f32x4){v0[4 * g4], v0[4 * g4 + 1], v0[4 * g4 + 2], v0[4 * g4 + 3]};
        *(f32x4*)(orow + 32 + 8 * g4 + 4 * hi) = (f32x4){v1[4 * g4], v1[4 * g4 + 1], v1[4 * g4 + 2], v1[4 * g4 + 3]};
    }
}
__device__ __forceinline__ void oacc_add(const float* orow, f32x16& v0, f32x16& v1, int hi) {
#pragma unroll
    for (int g4 = 0; g4 < 4; ++g4) {
        const f32x4 a = *(const f32x4*)(orow + 8 * g4 + 4 * hi), b = *(const f32x4*)(orow + 32 + 8 * g4 + 4 * hi);
#pragma unroll
        for (int e = 0; e < 4; ++e) { v0[4 * g4 + e] += a[e]; v1[4 * g4 + e] += b[e]; }
    }
}

__device__ __forceinline__ void opart_store(lds_u8* sm, int tid, const f32x16& v0, const f32x16& v1) {
#pragma unroll
    for (int g4 = 0; g4 < 4; ++g4) {
        *(LAS f32x4*)(sm + A_OPART + (g4 * 512 + tid) * 16) = (f32x4){v0[4 * g4], v0[4 * g4 + 1], v0[4 * g4 + 2], v0[4 * g4 + 3]};
        *(LAS f32x4*)(sm + A_OPART + ((4 + g4) * 512 + tid) * 16) = (f32x4){v1[4 * g4], v1[4 * g4 + 1], v1[4 * g4 + 2], v1[4 * g4 + 3]};
    }
}
__device__ __forceinline__ void opart_add(const lds_u8* sm, int tid, f32x16& v0, f32x16& v1) {
#pragma unroll
    for (int g4 = 0; g4 < 4; ++g4) {
        const f32x4 a = *(const LAS f32x4*)(sm + A_OPART + (g4 * 512 + tid) * 16), b = *(const LAS f32x4*)(sm + A_OPART + ((4 + g4) * 512 + tid) * 16);
#pragma unroll
        for (int e = 0; e < 4; ++e) { v0[4 * g4 + e] += a[e]; v1[4 * g4 + e] += b[e]; }
    }
}

__device__ __forceinline__ void fox_unit(KParams P, lds_u8* sm, int bh0, int qb0, int tid0, int wid, int lane0) {
    int bh = bh0, qb = qb0; asm volatile("" : "+s"(bh), "+s"(qb));
    int tid = tid0; asm volatile("" : "+v"(tid)); const int lane = tid & 63;
    const bf16_t* proj = (const bf16_t*)(P->ws + WS_PROJ);
    const int b = bh >> 3, h = bh & 7, r32 = lane & 31, hi = lane >> 5;
    const int q = qb * 256 + 32 * wid + r32;
    bf16x8 qf[4]; load_q(qf, proj + (size_t)(b * T + q) * PC + C_QA + h * 64, hi);
    const float* cum = (const float*)(P->ws + WS_CUM) + (size_t)bh * T;
    const float* tot = (const float*)(P->ws + WS_TOT) + bh * 16;
    LAS float* offs = (LAS float*)(sm + A_SELM) + 16;
    if (tid < 16) {
        float tv[15];
#pragma unroll
        for (int c = 0; c < 15; ++c) tv[c] = tot[c];
        float o = 0.f;
#pragma unroll
        for (int c = 0; c < 15; ++c) o += (c < tid) ? tv[c] : 0.f;
        offs[tid] = o;
    }
    float offq = 0.f;
    {
        float tv[15];
#pragma unroll
        for (int c = 0; c < 15; ++c) tv[c] = tot[c];
#pragma unroll
        for (int c = 0; c < 15; ++c) offq += (c < (qb >> 1)) ? tv[c] : 0.f;
    }
    const float cref = cum[qb * 256] + offq;
    FS st; fs_init(st);
    MaskCtx mc; mc.qpos = q; mc.diag0 = 4 * qb; mc.cur = 0; mc.mw0 = mc.mw1 = mc.mw2 = mc.mw3 = 0u;
    {
        bf16x8 kf[4]; load_q(kf, proj + (size_t)(b * T + q) * PC + C_KA + h * 64, hi);
        float qq = 0.f, qk = 0.f;
#pragma unroll
        for (int s4 = 0; s4 < 4; ++s4)
#pragma unroll
            for (int e = 0; e < 8; ++e) { const float a = bf2f((unsigned short)qf[s4][e]), kk = bf2f((unsigned short)kf[s4][e]); qq += a * a; qk += a * kk; }
        qq += __shfl_xor(qq, 32); qk += __shfl_xor(qk, 32);
        float qn = sqrtf(qq) * 1.0001f, bm = (cum[q] + offq) - qk;
#pragma unroll
        for (int o = 16; o >= 1; o >>= 1) { qn = fmaxf(qn, __shfl_xor(qn, o)); bm = fmaxf(bm, __shfl_xor(bm, o)); }
        LAS float* red = (LAS float*)(sm + A_SELM);
        if (lane == 0) { red[wid] = qn; red[8 + wid] = bm; }
        __syncthreads();
        if (wid == 0) {
            float QN = red[0], BM = red[8];
#pragma unroll
            for (int w = 1; w < 8; ++w) { QN = fmaxf(QN, red[w]); BM = fmaxf(BM, red[8 + w]); }
            const float* knt = (const float*)(P->ws + WS_KNT) + bh * 128;
            LAS int* tl = (LAS int*)(sm + A_TL);
            int base = 0;
#pragma unroll
            for (int hf = 0; hf < 2; ++hf) {
                const int jt = lane + 64 * hf;
                bool keep = false;
                if (jt < 4 * qb) keep = !(QN * knt[jt] + BM - (cum[64 * jt + 63] + offs[jt >> 3]) < -48.0f);
                else if (jt < 4 * qb + 4) keep = true;
                const unsigned long long mk = __ballot(keep);
                if (keep) tl[1 + base + __popcll(mk & ((1ull << lane) - 1ull))] = jt;
                base += __popcll(mk);
            }
            if (lane == 0) tl[0] = base;
        }
        __syncthreads();
    }
    {
        const LAS int* tl = (const LAS int*)(sm + A_TL);
        flash_run<0, 0>(sm, proj + (size_t)(b * T) * PC + C_KA + h * 64, proj + (size_t)(b * T) * PC + C_VA + h * 64, PC, 0, tl[0], true, tl + 1, cum, cref, qf, st, mc, tid, lane, 0);
    }
    const float il = st.l > 0.f ? 1.0f / st.l : 0.f;
    st.o0 *= il; st.o1 *= il;
    store_o((bf16_t*)(P->ws + WS_OA) + (size_t)(b * T + q) * 1024 + h * 64, st.o0, st.o1, hi);
}

__device__ __forceinline__ void nsa_unit(KParams P, lds_u8* sm, int bg0, int qt0, int tid0, int wid, int lane0) {
    int bg = bg0, qt = qt0; asm volatile("" : "+s"(bg), "+s"(qt));
    int tid = tid0; asm volatile("" : "+v"(tid)); const int lane = tid & 63;
    const bf16_t* proj = (const bf16_t*)(P->ws + WS_PROJ);
    const int b = bg >> 1, g = bg & 1, r32 = lane & 31, hi = lane >> 5, head = r32 & 3, hq = g * 4 + head;
    const int qloc = 8 * wid + (r32 >> 2), q = qt * 64 + qloc;
    const size_t prow = (size_t)(b * T + q) * PC;
    bf16x8 qf[4]; load_q(qf, proj + prow + C_QB + hq * 64, hi);
#define NSA_GATE(br) sigmoidf_(bf2f(proj[(size_t)(b * T + q) * PC + C_G3 + hq * 3 + (br)]))
#define NSA_OACC ((float*)(P->ws + WS_MIX) + (size_t)(b * T + q) * 512 + hq * 64)
    MaskCtx mc; mc.qpos = q; mc.diag0 = qt * 64; mc.cur = qt; mc.mw0 = mc.mw1 = mc.mw2 = mc.mw3 = 0u;
    for (int e = tid; e < 64 * 129; e += 512) ((LAS float*)(sm + A_IMP))[e] = 0.f;
    if (tid < 256) ((LAS unsigned*)(sm + A_SELM))[tid] = 0u;
    __syncthreads();
    f32x16 oc0, oc1;
    {
        const bf16_t* KC = (const bf16_t*)(P->ws + WS_KC) + (size_t)(0 * 4 + bg) * 512 * 64;
        const bf16_t* VC = (const bf16_t*)(P->ws + WS_KC) + (size_t)(1 * 4 + bg) * 512 * 64;
        const int ntc = (4 * qt + 3 + 63) >> 6;
        FS st;
        int repc_ = REP_CMP; asm volatile("" : "+s"(repc_));
#pragma unroll 1
        for (int rc_ = 0; rc_ < repc_; ++rc_) {
        fs_init(st);
        flash_run<1, 1>(sm, KC, VC, 64, 0, ntc, false, (const LAS int*)(sm + A_TL), nullptr, 0.f, qf, st, mc, tid, lane, qloc);
        flash_run<1, 2>(sm, KC, VC, 64, 0, ntc, false, (const LAS int*)(sm + A_TL), nullptr, 0.f, qf, st, mc, tid, lane, qloc);
        }
        const float g0 = NSA_GATE(0); oc0 = st.o0 * g0; oc1 = st.o1 * g0;
    }
    { int reps_ = REP_TOPK; asm volatile("" : "+s"(reps_));
#pragma unroll 1
    for (int rep_ = 0; rep_ < reps_; ++rep_)
    {
        const int ql = tid >> 3, sub = tid & 7, cur = qt;
        const LAS float* imp = (const LAS float*)(sm + A_IMP) + ql * 129;
        unsigned vb[16];
#pragma unroll
        for (int i = 0; i < 16; ++i) { const int s = sub * 16 + i; const float v = (s == 0 || s == cur) ? 1e6f : imp[s]; vb[i] = (s <= cur) ? __float_as_uint(v) : 0u; }
        unsigned bits = 0u;
        if (cur < 16) {
#pragma unroll
            for (int i = 0; i < 16; ++i) { if (sub * 16 + i <= cur) bits |= 1u << i; }
        } else {
            unsigned t = 0u;
            for (int bit = 30; bit >= 0; --bit) {
                const unsigned cand = t | (1u << bit);
                int c = 0;
#pragma unroll
                for (int i = 0; i < 16; ++i) c += (vb[i] >= cand) ? 1 : 0;
                c = oct_sum(c);
                if (c >= 16) t = cand;
            }
            int cg = 0, ce = 0;
#pragma unroll
            for (int i = 0; i < 16; ++i) { cg += (vb[i] > t) ? 1 : 0; ce += (vb[i] == t) ? 1 : 0; }
            const int need = 16 - oct_sum(cg);
            int pre = 0;
#pragma unroll
            for (int k = 0; k < 7; ++k) { const int ck = __shfl(ce, (lane & ~7) + k); pre += (k < sub) ? ck : 0; }
#pragma unroll
            for (int i = 0; i < 16; ++i) {
                const bool eq = vb[i] == t;
                if (sub * 16 + i <= cur && (vb[i] > t || (eq && pre < need))) bits |= 1u << i;
                pre += eq ? 1 : 0;
            }
        }
        if (bits) __hip_atomic_fetch_or((LAS unsigned*)(sm + A_SELM) + ql * 4 + (sub >> 1), bits << ((sub & 1) * 16), __ATOMIC_RELAXED, __HIP_MEMORY_SCOPE_WORKGROUP);
    }
    }
    __syncthreads();
    opart_store(sm, tid, oc0, oc1);
    {
        const LAS unsigned* selm = (const LAS unsigned*)(sm + A_SELM);
        mc.mw0 = selm[qloc * 4 + 0]; mc.mw1 = selm[qloc * 4 + 1]; mc.mw2 = selm[qloc * 4 + 2]; mc.mw3 = selm[qloc * 4 + 3];
        if (wid == 0) {
            unsigned u0 = selm[lane * 4 + 0], u1 = selm[lane * 4 + 1], u2 = selm[lane * 4 + 2], u3 = selm[lane * 4 + 3];
#pragma unroll
            for (int o = 32; o >= 1; o >>= 1) { u0 |= __shfl_xor(u0, o); u1 |= __shfl_xor(u1, o); u2 |= __shfl_xor(u2, o); u3 |= __shfl_xor(u3, o); }
            {
                LAS int* tl = (LAS int*)(sm + A_TL);
                const unsigned wlo = (lane < 32) ? u0 : u1, whi = (lane < 32) ? u2 : u3;
                const bool k0 = (wlo >> (lane & 31)) & 1u, k1 = (whi >> (lane & 31)) & 1u;
                const unsigned long long m0 = __ballot(k0), m1 = __ballot(k1);
                const unsigned long long below = (1ull << lane) - 1ull;
                const int n0 = __popcll(m0);
                if (k0) tl[1 + __popcll(m0 & below)] = lane;
                if (k1) tl[1 + n0 + __popcll(m1 & below)] = lane + 64;
                if (lane == 0) tl[0] = n0 + __popcll(m1);
            }
        }
    }
    __syncthreads();
    {
        const LAS int* tl = (const LAS int*)(sm + A_TL);
        const int nts = tl[0];
        FS st;
        int reps_ = REP_SEL; asm volatile("" : "+s"(reps_));
#pragma unroll 1
        for (int rep_ = 0; rep_ < reps_; ++rep_) {
        fs_init(st);
        int bg2 = bg; asm volatile("" : "+s"(bg2)); const bf16_t* pj = (const bf16_t*)(P->ws + WS_PROJ) + (size_t)((bg2 >> 1) * T) * PC + (bg2 & 1) * 64;
        flash_run<2, 0>(sm, pj + C_KS, pj + C_VS, PC, 0, nts, true, tl + 1, nullptr, 0.f, qf, st, mc, tid, lane, qloc);
        }
        const float il = st.l > 0.f ? NSA_GATE(1) / st.l : 0.f;
        st.o0 *= il; st.o1 *= il; opart_add(sm, tid, st.o0, st.o1); opart_store(sm, tid, st.o0, st.o1);
    }
    {
        const int f = qt >= 8 ? qt - 8 : 0;
        FS st; fs_init(st);
        int bg2 = bg; asm volatile("" : "+s"(bg2)); const bf16_t* pj = (const bf16_t*)(P->ws + WS_PROJ) + (size_t)((bg2 >> 1) * T) * PC + (bg2 & 1) * 64;
        flash_run<3, 0>(sm, pj + C_KW, pj + C_VW, PC, f, qt - f + 1, false, (const LAS int*)(sm + A_TL), nullptr, 0.f, qf, st, mc, tid, lane, qloc);
        const float il = st.l > 0.f ? NSA_GATE(2) / st.l : 0.f;
        st.o0 *= il; st.o1 *= il; opart_add(sm, tid, st.o0, st.o1);
        store_o((bf16_t*)(P->ws + WS_OA) + (size_t)(b * T + q) * 1024 + 512 + hq * 64, st.o0, st.o1, hi);
    }
    __syncthreads();
}

__device__ __forceinline__ void phase_attention(KParams P, lds_u8* sm, int G, int bid, int tid, int wid, int lane) {
    for (int w = bid; w < 256; w += G) {
        const int bh = w >> 4, qb = w & 15;
#pragma unroll 1
        for (int k = 0; k < 2 * REP_FOX; ++k) fox_unit(P, sm, bh, (k & 1) ? qb : 31 - qb, tid, wid, lane);
        const int bg = w >> 6, qt = w & 63;
#pragma unroll 1
        for (int k = 0; k < 2 * REP_NSA; ++k) nsa_unit(P, sm, bg, (k & 1) ? qt : 127 - qt, tid, wid, lane);
    }
}

#define XB_TMO      128
#define XB_XCNT(j)  (256  + 64 * (j))
#define XB_XSUB(j)  (1280 + 64 * (j))
#define XB_XGEN(j)  (2304 + 64 * (j))
#define XB_TOP      3328
#define XB_TOPGEN   3392
#define XCD_BAR_WORDS 3456
#define XB_SPIN_CAP (1u << 18)

__device__ __forceinline__ unsigned xb_ld(unsigned* p)              { return __hip_atomic_load(p, __ATOMIC_RELAXED, __HIP_MEMORY_SCOPE_AGENT); }
__device__ __forceinline__ unsigned xb_add(unsigned* p, unsigned v) { return __hip_atomic_fetch_add(p, v, __ATOMIC_RELAXED, __HIP_MEMORY_SCOPE_AGENT); }
__device__ __forceinline__ unsigned xb_xcc_id() { return (unsigned)__builtin_amdgcn_s_getreg((3 << 11) | 20) & 0xFu; }
#define XB_SPIN(cond, bar) do { unsigned _sp = 0; while (cond) { __builtin_amdgcn_s_sleep(1); \
    if ((++_sp & 255u) == 0u) { if (xb_ld(&(bar)[XB_TMO])) break; if (_sp > XB_SPIN_CAP) { atomicAdd(&(bar)[XB_TMO], 1u); break; } } } } while (0)

struct XcdBarrier {
    unsigned* bar; unsigned x;
    volatile LAS unsigned* st;
};

__device__ __forceinline__ XcdBarrier xcd_barrier_post(unsigned* bar, volatile LAS unsigned* st) {
    XcdBarrier b; b.bar = bar; b.x = xb_xcc_id(); b.st = st;
    if (threadIdx.x == 0) (void)xb_add(&bar[XB_XCNT(b.x)], 1u);
    return b;
}
__device__ __forceinline__ void xcd_barrier_complete(unsigned* bar, unsigned x, unsigned& nloc, unsigned& nx) {
    const unsigned G = gridDim.x * gridDim.y * gridDim.z;
    unsigned sum, cnt, mine, sp = 0u;
    for (;;) {
        sum = 0u; cnt = 0u; mine = 0u;
#pragma unroll
        for (unsigned j = 0; j < 16; ++j) { const unsigned c = xb_ld(&bar[XB_XCNT(j)]); sum += c; cnt += (c > 0u) ? 1u : 0u; mine = (j == x) ? c : mine; }
        if (sum == G) break;
        __builtin_amdgcn_s_sleep(1);
        if ((++sp & 255u) == 0u) { if (xb_ld(&bar[XB_TMO])) break; if (sp > XB_SPIN_CAP) { atomicAdd(&bar[XB_TMO], 1u); break; } }
    }
    nloc = mine > 0u ? mine : 1u; nx = cnt > 0u ? cnt : 1u;
}

__device__ __forceinline__ void xcd_barrier(const XcdBarrier& b) {
    asm volatile("s_waitcnt vmcnt(0)" ::: "memory");
    __syncthreads();
    if (threadIdx.x == 0) {
        unsigned* bar = b.bar; asm volatile("" : "+s"(bar)); unsigned bx_ = b.x; asm volatile("" : "+s"(bx_));
        __builtin_amdgcn_s_waitcnt(0);
        unsigned nloc = b.st[0], nx = b.st[1];
        if (nloc == 0u) { xcd_barrier_complete(bar, bx_, nloc, nx); b.st[0] = nloc; b.st[1] = nx; }
        const unsigned old = xb_add(&bar[XB_XSUB(bx_)], 1u);
        const unsigned gen = old / nloc;
        if (old + 1u == (gen + 1u) * nloc) {
            __builtin_amdgcn_fence(__ATOMIC_RELEASE, "agent");
            asm volatile("s_waitcnt vmcnt(0)" ::: "memory");
            const unsigned og = xb_add(&bar[XB_TOP], 1u);
            const unsigned tg = og / nx;
            if (og + 1u == (tg + 1u) * nx) xb_add(&bar[XB_TOPGEN], 1u);
            else XB_SPIN(xb_ld(&bar[XB_TOPGEN]) == tg, bar);
            __builtin_amdgcn_fence(__ATOMIC_ACQUIRE, "agent");
            xb_add(&bar[XB_XGEN(bx_)], 1u);
            asm volatile("s_waitcnt vmcnt(0)" ::: "memory");
        } else {
            XB_SPIN(xb_ld(&bar[XB_XGEN(bx_)]) == gen, bar);
            __builtin_amdgcn_fence(__ATOMIC_ACQUIRE, "agent");
            asm volatile("s_waitcnt vmcnt(0)" ::: "memory");
        }
    }
    __syncthreads();
}

__global__ void __launch_bounds__(512, 2) hybrid_fwd(Params Parg) {
    extern __shared__ __attribute__((aligned(16))) unsigned char smem_raw[];
    cg::grid_group grid = cg::this_grid();
#define FRESH() KParams P = (KParams)__builtin_amdgcn_kernarg_segment_ptr(); asm volatile("" : "+s"(P)); int G = gridDim.x, bid = blockIdx.x; asm volatile("" : "+s"(G), "+s"(bid)); \
                int tid = threadIdx.x; asm volatile("" : "+v"(tid)); lds_u8* sm = (lds_u8*)smem_raw; asm volatile("" : "+s"(sm)); (void)sm; const int wid = __builtin_amdgcn_readfirstlane(tid >> 6), lane = tid & 63; unsigned char* ws = P->ws; (void)wid; (void)lane; (void)ws; (void)G; (void)bid
#define LDSP ((PG8_LAS unsigned char*)smem_raw)
    XcdBarrier xbar;
    {
        FRESH();
        volatile LAS unsigned* bst = (volatile LAS unsigned*)(sm + 131072);
        if (tid == 0) { bst[0] = 0u; bst[1] = 0u; }
        __syncthreads();
        xbar = xcd_barrier_post((unsigned*)(ws + WS_BAR), bst);
        phase_x_to_bf16(P, G, bid, wid, lane);
    }
    for (int layer = 0; layer < 2; ++layer) {
#ifndef NO_W
        { int rw_ = REP_W; asm volatile("" : "+s"(rw_));
#pragma unroll 1
          for (int r_ = 0; r_ < rw_; ++r_) { FRESH(); phase_weights(P, layer, sm, G, bid, tid); } }
#endif
        xcd_barrier(xbar);
        if (gridDim.y == 0x7fffu) grid.sync();
        {
            FRESH();
            pg8::Gemm gm; gm.A = (const bf16_t*)(ws + WS_XB); gm.Bt = (const bf16_t*)(ws + WS_WIN); gm.M = M; gm.N = NPAD; gm.K = DM;
            pg8::StaticOrder so; so.init(M, NPAD, G, bid);
            EpiScaleBf16<0> ep; ep.O = (bf16_t*)(ws + WS_PROJ); ep.ldc = PC; ep.ncols = PC; ep.part = (const float*)(ws + WS_PART);
            pg8::gemm_phase<EpiScaleBf16<0>, pg8::StaticOrder, true, true>(LDSP, gm, so, ep);
        }
        xcd_barrier(xbar);
#ifndef NO_PREP
        { FRESH(); phase_prep(P, layer, sm, G, bid, tid, wid, lane); }
#endif
        xcd_barrier(xbar);
#ifndef NO_ATT
        { FRESH(); phase_attention(P, sm, G, bid, tid, wid, lane); }
#endif
        xcd_barrier(xbar);
        {
            FRESH();
            pg8::StaticOrder so; so.init(M, DM, G, bid);
            pg8::Gemm g1; g1.A = (const bf16_t*)(ws + WS_OA); g1.Bt = (const bf16_t*)(ws + WS_WOF); g1.M = M; g1.N = DM; g1.K = DM;
            EpiGateFused e1; e1.mix = (bf16_t*)(ws + WS_MIX); e1.proj = (const bf16_t*)(ws + WS_PROJ);
            pg8::gemm_phase<EpiGateFused, pg8::StaticOrder, true, true>(LDSP, g1, so, e1);
        }
        xcd_barrier(xbar);
        {
            FRESH();
            pg8::Gemm gm; gm.A = (const bf16_t*)(ws + WS_MIX); gm.Bt = (const bf16_t*)(ws + WS_WOUT); gm.M = M; gm.N = DM; gm.K = DM;
            pg8::StaticOrder so; so.init(M, DM, G, bid);
            EpiResidual ep; ep.xi = layer == 0 ? P->in[0] : (const float*)P->out; ep.xo = P->out; ep.xb = (bf16_t*)(ws + WS_XB); ep.part = (float*)(ws + WS_PART); ep.wxb = true;
            pg8::gemm_phase<EpiResidual, pg8::StaticOrder, true, true>(LDSP, gm, so, ep);
        }
        xcd_barrier(xbar);
        {
            FRESH();
            pg8::Gemm gm; gm.A = (const bf16_t*)(ws + WS_XB); gm.Bt = (const bf16_t*)(ws + WS_WUP); gm.M = M; gm.N = DFF; gm.K = DM;
            pg8::StaticOrder so; so.init(M, DFF, G, bid);
            EpiScaleBf16<1> ep; ep.O = (bf16_t*)(ws + WS_PROJ); ep.ldc = DFF; ep.ncols = DFF; ep.part = (const float*)(ws + WS_PART);
            pg8::gemm_phase<EpiScaleBf16<1>, pg8::StaticOrder, true, true>(LDSP, gm, so, ep);
        }
        xcd_barrier(xbar);
        {
            FRESH();
            pg8::Gemm gm; gm.A = (const bf16_t*)(ws + WS_PROJ); gm.Bt = (const bf16_t*)(ws + WS_WDN); gm.M = M; gm.N = DM; gm.K = DFF;
            pg8::StaticOrder so; so.init(M, DM, G, bid);
            EpiResidual ep; ep.xi = P->out; ep.xo = P->out; ep.xb = (bf16_t*)(ws + WS_XB); ep.part = (float*)(ws + WS_PART); ep.wxb = (layer == 0);
            pg8::gemm_phase<EpiResidual, pg8::StaticOrder, true, true>(LDSP, gm, so, ep);
        }
        xcd_barrier(xbar);
    }
    {
        FRESH();
        const float* gf = P->in[15]; float* XA = P->out; const float* PART = (const float*)(ws + WS_PART);
        f32x4 gv[4];
#pragma unroll
        for (int i = 0; i < 4; ++i) gv[i] = ((const f32x4*)gf)[lane + 64 * i];
        for (int row0 = bid * 8 + wid; row0 < M; row0 += 4 * G * 8) {
            f32x4 v[4][4]; float rs[4];
#pragma unroll
            for (int k = 0; k < 4; ++k) {
                const int row = row0 + k * G * 8, rr = row < M ? row : row0;
                rs[k] = row_rstd(PART, rr);
#pragma unroll
                for (int i = 0; i < 4; ++i) v[k][i] = ((const f32x4*)(XA + (size_t)rr * DM))[lane + 64 * i];
            }
            asm volatile("" ::: "memory");
#pragma unroll
            for (int k = 0; k < 4; ++k) {
                const int row = row0 + k * G * 8;
                if (row < M) {
#pragma unroll
                    for (int i = 0; i < 4; ++i) ((f32x4*)(XA + (size_t)row * DM))[lane + 64 * i] = v[k][i] * rs[k] * gv[i];
                }
            }
        }
    }
}

extern "C" void kernel_launch(void* const* d_in, const int* in_sizes, int n_in, void* d_out, int out_size, void* d_ws, size_t ws_size, hipStream_t stream) {
    static int grid_blocks = 0;
    if (!grid_blocks) {
        int dev = 0, cus = 0, per_cu = 0;
        hipGetDevice(&dev);
        hipDeviceGetAttribute(&cus, hipDeviceAttributeMultiprocessorCount, dev);
        if (hipFuncSetAttribute((const void*)hybrid_fwd, hipFuncAttributeMaxDynamicSharedMemorySize, LDS_BYTES) != hipSuccess) fprintf(stderr, "hipFuncSetAttribute failed\n");
        hipOccupancyMaxActiveBlocksPerMultiprocessor(&per_cu, hybrid_fwd, 512, LDS_BYTES);
        if (per_cu < 1) per_cu = 1;
        grid_blocks = cus * per_cu;
        if (grid_blocks > 256) grid_blocks = 256;
    }
    if (hipMemsetAsync((char*)d_ws + WS_BAR, 0, 16384, stream) != hipSuccess) fprintf(stderr, "memset failed\n");
    Params p{};
    for (int i = 0; i < 16; ++i) p.in[i] = (const float*)d_in[i];
    p.out = (float*)d_out; p.ws = (unsigned char*)d_ws;
    void* args[] = {&p};
    hipError_t e = hipLaunchCooperativeKernel((void*)hybrid_fwd, dim3(grid_blocks), dim3(512), args, LDS_BYTES, stream);
    if (e != hipSuccess) fprintf(stderr, "cooperative launch failed: %s (grid %d)\n", hipGetErrorString(e), grid_blocks);
}
```

```cpp
#include <hip/hip_runtime.h>
#include <hip/hip_cooperative_groups.h>
#include <cstdio>
#include <cstdint>
#include <cmath>
namespace cg = cooperative_groups;
namespace pg8 {
#define PG8_LAS __attribute__((address_space(3)))
typedef unsigned short bf16_t;
typedef short bf16x8 __attribute__((ext_vector_type(8)));
typedef float f32x4 __attribute__((ext_vector_type(4)));
typedef unsigned u32x4 __attribute__((ext_vector_type(4)));
constexpr int BM = 256, BK = 64, HALF = 128, HTB = HALF * BK * 2  , STAGE_BYTES = 8 * HTB, NXCD = 8, WGM = 8;

__host__ __device__ __forceinline__ int lds_byte(int r, int c) { const int st = (r >> 4) * 2 + (c >> 5), rr = r & 15, cc = c & 31, ob = rr * 64 + cc * 2; return st * 1024 + (ob ^ (((ob >> 9) & 1) << 5)); }
__host__ __device__ __forceinline__ void stage_rc(int b, int& R, int& C) { const int st = b / 1024, sb = b % 1024, swz = sb ^ (((sb >> 9) & 1) << 5); R = (st >> 1) * 16 + swz / 64; C = (st & 1) * 32 + (swz % 64) / 2; }
__host__ __device__ __forceinline__ int perm32(int rho) { const int n = rho >> 4, i = rho & 15; return 8 * (i >> 2) + 4 * n + (i & 3); }

struct Unit { int pm, pn; };
struct Gemm { const bf16_t* A; const bf16_t* Bt; int M, N, K; };

struct StaticOrder {
    int nM, nN, nwg, G, c;
    __host__ __device__ void init(int M, int N, int G_, int c_) { nM = M / BM; nN = N / BM; nwg = nM * nN; G = G_; c = c_; }
    __host__ __device__ bool next(int i, Unit& u) const {
        const long L = (long)i * G + c; if (L >= nwg) return false;
        int wgid = (int)L; { const int q = nwg / NXCD, r = nwg % NXCD, xcd = wgid % NXCD, off = wgid / NXCD; wgid = (xcd < r ? xcd * (q + 1) : r * (q + 1) + (xcd - r) * q) + off; }
        const int nig = WGM * nN, gid = wgid / nig, fm = gid * WGM, gsz = (nM - fm) < WGM ? (nM - fm) : WGM;
        u.pm = fm + ((wgid % nig) % gsz); u.pn = (wgid % nig) / gsz; return true;
    }
    __device__ __forceinline__ void a_ready(const Unit&) const {}
    __device__ __forceinline__ void done(const Unit&) const {}
};

__device__ __forceinline__ unsigned cvt_pk_bf16(float lo, float hi) { unsigned r; asm volatile("v_cvt_pk_bf16_f32 %0, %1, %2" : "=v"(r) : "v"(lo), "v"(hi)); return r; }

template <class Epi, class Sched, bool ALIGN_EPI = false, bool SP2 = false>
__device__ __forceinline__ void gemm_phase(PG8_LAS unsigned char* lds, const Gemm g, const Sched& S, const Epi& E) {
    int tid_ = threadIdx.x; asm volatile("" : "+v"(tid_));
    const int tid = tid_, wid = __builtin_amdgcn_readfirstlane(tid >> 6), lane = tid & 63, wr = wid >> 2, wc = wid & 3, fr = lane & 15, fq = lane >> 4;
    const int K = g.K, nt = K / BK;
    unsigned voffA[2], voffB[2];
#pragma unroll
    for (int i = 0; i < 2; ++i) { int R, C; stage_rc(tid * 16 + i * 8192, R, C); const int Rb = Epi::PERM ? ((R & ~31) + perm32(R & 31)) : R;
        voffA[i] = (unsigned)(R * K + C) * 2u; voffB[i] = (unsigned)(Rb * K + C) * 2u; }
    const size_t kstep = (size_t)(BK * 2);
    const size_t hstep = (size_t)HALF * K * 2;
    const size_t tstep = 2 * hstep;
    const unsigned ldsw = (unsigned)wid * 1024u;
    const int aoff = lds_byte(wr * 64 + fr, fq * 8), boff = lds_byte(wc * 32 + fr, fq * 8);
#define PG8_SA(b, h) (((b) * 2 + (h)) * HTB)
#define PG8_SB(b, h) ((4 + (b) * 2 + (h)) * HTB)
#define PG8_STAGE(bufoff, gbase, voff) do { _Pragma("unroll") for (int _i = 0; _i < 2; ++_i) \
        __builtin_amdgcn_global_load_lds((const unsigned*)((const char*)(gbase) + (voff)[_i]), (PG8_LAS unsigned*)(lds + (bufoff) + ldsw + _i * 8192), 16, 0, 0); } while (0)
#define PG8_LDA(dst, b, h) do { _Pragma("unroll") for (int m = 0; m < 4; ++m) _Pragma("unroll") for (int k = 0; k < 2; ++k) dst[m][k] = *(const PG8_LAS bf16x8*)(lds + PG8_SA(b, h) + aoff + m * 2048 + k * 1024); } while (0)
#define PG8_LDB(dst, b, h) do { _Pragma("unroll") for (int n = 0; n < 2; ++n) _Pragma("unroll") for (int k = 0; k < 2; ++k) dst[n][k] = *(const PG8_LAS bf16x8*)(lds + PG8_SB(b, h) + boff + n * 2048 + k * 1024); } while (0)
#define PG8_MMA(ai, bj, At, Bt) do { __builtin_amdgcn_s_setprio(1); _Pragma("unroll") for (int m = 0; m < 4; ++m) _Pragma("unroll") for (int n = 0; n < 2; ++n) _Pragma("unroll") for (int k = 0; k < 2; ++k) \
        acc[ai][bj][m][n] = __builtin_amdgcn_mfma_f32_16x16x32_bf16(Bt[n][k], At[m][k], acc[ai][bj][m][n], 0, 0, 0); __builtin_amdgcn_s_setprio(0); } while (0)
#define PG8_WAIT_V(n) asm volatile("s_waitcnt vmcnt(" #n ")" ::: "memory")
#define PG8_WAIT_L(n) asm volatile("s_waitcnt lgkmcnt(" #n ")" ::: "memory")
#define PG8_BAR __builtin_amdgcn_s_barrier()
#define PG8_SCHED __builtin_amdgcn_sched_barrier(0)
    Unit cur, nxt; int ui = 0;
    if (!S.next(0, cur)) return;
    f32x4 acc[2][2][4][2];
#pragma unroll
    for (int a = 0; a < 2; ++a)
#pragma unroll
        for (int b = 0; b < 2; ++b)
#pragma unroll
            for (int m = 0; m < 4; ++m)
#pragma unroll
                for (int n = 0; n < 2; ++n) acc[a][b][m][n] = (f32x4){0.f, 0.f, 0.f, 0.f};
    bf16x8 At[4][2], B0[2][2], B1[2][2];
    const char* cA = (const char*)g.A + (size_t)cur.pm * tstep; const char* cB = (const char*)g.Bt + (size_t)cur.pn * tstep;
    S.a_ready(cur);
    if constexpr (SP2) {
        PG8_STAGE(PG8_SB(0, 0), cB, voffB); PG8_STAGE(PG8_SB(0, 1), cB + hstep, voffB); PG8_STAGE(PG8_SA(0, 0), cA, voffA); PG8_STAGE(PG8_SA(0, 1), cA + hstep, voffA);
        if (wr == 1) PG8_BAR;
        PG8_WAIT_V(2); PG8_BAR;
        PG8_STAGE(PG8_SB(1, 0), cB + kstep, voffB); PG8_STAGE(PG8_SA(1, 0), cA + kstep, voffA); PG8_STAGE(PG8_SB(1, 1), cB + hstep + kstep, voffB);
        PG8_WAIT_V(6); PG8_BAR;
    } else {
        PG8_STAGE(PG8_SB(0, 0), cB, voffB); PG8_STAGE(PG8_SA(0, 0), cA, voffA); PG8_STAGE(PG8_SB(0, 1), cB + hstep, voffB); PG8_STAGE(PG8_SA(0, 1), cA + hstep, voffA);
        if (wr == 1) PG8_BAR;
        PG8_WAIT_V(4); PG8_BAR;
        PG8_STAGE(PG8_SB(1, 0), cB + kstep, voffB); PG8_STAGE(PG8_SA(1, 0), cA + kstep, voffA); PG8_STAGE(PG8_SB(1, 1), cB + hstep + kstep, voffB);
        PG8_WAIT_V(6); PG8_BAR;
    }
    for (;;) {
        const bool has_next = S.next(ui + 1, nxt);
        const char* nA = has_next ? (const char*)g.A + (size_t)nxt.pm * tstep : cA; const char* nB = has_next ? (const char*)g.Bt + (size_t)nxt.pn * tstep : cB;
#pragma unroll 1
        for (int kr_ = 0; kr_ < ((Epi::MID_T >= 0) ? 2 : 1); ++kr_) {
        const int tb_ = (Epi::MID_T >= 0 && kr_ == 1) ? Epi::MID_T : 0, te_ = (Epi::MID_T >= 0 && kr_ == 0) ? Epi::MID_T : nt;
        if constexpr (Epi::MID_T >= 0) { if (kr_ == 1) E.mid(acc, cur, wr, wc, fr, fq); }
        for (int t = tb_; t < te_; t += 2) {
            const bool last = (t == nt - 2);
            const char* a1 = cA + (size_t)(t + 1) * kstep;
            const char* a2 = last ? nA : cA + (size_t)(t + 2) * kstep; const char* b2 = last ? nB : cB + (size_t)(t + 2) * kstep;
            const char* a3 = a2 + kstep; const char* b3 = b2 + kstep;
            if (last && has_next) S.a_ready(nxt);
            if constexpr (SP2) {
            PG8_LDB(B0, 0, 0); PG8_LDB(B1, 0, 1); PG8_SCHED; PG8_LDA(At, 0, 0); PG8_STAGE(PG8_SA(1, 1), a1 + hstep, voffA);
            PG8_WAIT_V(8); PG8_WAIT_L(0); PG8_BAR; PG8_MMA(0, 0, At, B0); PG8_MMA(0, 1, At, B1); PG8_BAR; PG8_SCHED;
            PG8_LDA(At, 0, 1); PG8_STAGE(PG8_SB(0, 0), b2, voffB); PG8_STAGE(PG8_SB(0, 1), b2 + hstep, voffB); PG8_STAGE(PG8_SA(0, 0), a2, voffA);
            PG8_WAIT_V(8); PG8_WAIT_L(0); PG8_BAR; PG8_MMA(1, 0, At, B0); PG8_MMA(1, 1, At, B1); PG8_BAR; PG8_SCHED;
            PG8_LDB(B0, 1, 0); PG8_LDB(B1, 1, 1); PG8_SCHED; PG8_LDA(At, 1, 0); PG8_STAGE(PG8_SA(0, 1), a2 + hstep, voffA);
            PG8_WAIT_V(8); PG8_WAIT_L(0); PG8_BAR; PG8_MMA(0, 0, At, B0); PG8_MMA(0, 1, At, B1); PG8_BAR; PG8_SCHED;
            PG8_LDA(At, 1, 1); PG8_STAGE(PG8_SB(1, 0), b3, voffB); PG8_STAGE(PG8_SB(1, 1), b3 + hstep, voffB); PG8_STAGE(PG8_SA(1, 0), a3, voffA);
            PG8_WAIT_V(8); PG8_WAIT_L(0); PG8_BAR; PG8_MMA(1, 0, At, B0); PG8_MMA(1, 1, At, B1); PG8_BAR; PG8_SCHED;
            } else {
            PG8_LDB(B0, 0, 0); PG8_SCHED; PG8_LDA(At, 0, 0); PG8_STAGE(PG8_SA(1, 1), a1 + hstep, voffA);
            PG8_WAIT_L(8); PG8_BAR; PG8_WAIT_L(0); PG8_MMA(0, 0, At, B0); PG8_BAR; PG8_SCHED;
            PG8_LDB(B1, 0, 1); PG8_STAGE(PG8_SB(0, 0), b2, voffB);
            PG8_BAR; PG8_WAIT_L(0); PG8_MMA(0, 1, At, B1); PG8_BAR;
            PG8_LDA(At, 0, 1); PG8_STAGE(PG8_SA(0, 0), a2, voffA);
            PG8_BAR; PG8_WAIT_L(0); PG8_MMA(1, 0, At, B0); PG8_BAR; PG8_SCHED;
            PG8_STAGE(PG8_SB(0, 1), b2 + hstep, voffB);
            PG8_WAIT_V(6); PG8_BAR; PG8_MMA(1, 1, At, B1); PG8_BAR;
            PG8_LDB(B0, 1, 0); PG8_SCHED; PG8_LDA(At, 1, 0); PG8_STAGE(PG8_SA(0, 1), a2 + hstep, voffA);
            PG8_WAIT_L(8); PG8_BAR; PG8_WAIT_L(0); PG8_MMA(0, 0, At, B0); PG8_BAR; PG8_SCHED;
            PG8_LDB(B1, 1, 1); PG8_STAGE(PG8_SB(1, 0), b3, voffB);
            PG8_BAR; PG8_WAIT_L(0); PG8_MMA(0, 1, At, B1); PG8_BAR;
            PG8_LDA(At, 1, 1); PG8_STAGE(PG8_SA(1, 0), a3, voffA);
            PG8_BAR; PG8_WAIT_L(0); PG8_MMA(1, 0, At, B0); PG8_BAR; PG8_SCHED;
            PG8_STAGE(PG8_SB(1, 1), b3 + hstep, voffB);
            PG8_WAIT_V(6); PG8_BAR; PG8_MMA(1, 1, At, B1); PG8_BAR;
            }
        }
        }
        if constexpr (ALIGN_EPI) { if (wr == 0) PG8_BAR; }
        if constexpr (!Epi::AFTER_DRAIN) { E(acc, cur, wr, wc, fr, fq); S.done(cur); }
        if (!has_next) break;
#pragma unroll
        for (int a = 0; a < 2; ++a)
#pragma unroll
            for (int b = 0; b < 2; ++b)
#pragma unroll
                for (int m = 0; m < 4; ++m)
#pragma unroll
                    for (int n = 0; n < 2; ++n) acc[a][b][m][n] = (f32x4){0.f, 0.f, 0.f, 0.f};
        cur = nxt; cA = nA; cB = nB; ++ui;
        if constexpr (ALIGN_EPI) { if (wr == 1) PG8_BAR; }
    }
    PG8_WAIT_V(0);
    if constexpr (!ALIGN_EPI) { if (wr == 0) PG8_BAR; }
    PG8_BAR;
    if constexpr (Epi::AFTER_DRAIN) { E.fused(acc, cur, wr, wc, fr, fq, lds, wid, lane); S.done(cur); }
#undef PG8_SA
#undef PG8_SB
#undef PG8_STAGE
#undef PG8_LDA
#undef PG8_LDB
#undef PG8_MMA
#undef PG8_WAIT_V
#undef PG8_WAIT_L
#undef PG8_BAR
#undef PG8_SCHED
}
}

using pg8::bf16_t; using pg8::bf16x8; using pg8::f32x4; using pg8::u32x4;
typedef short s16x4 __attribute__((ext_vector_type(4)));
typedef float f32x16 __attribute__((ext_vector_type(16)));
typedef unsigned u32x2 __attribute__((ext_vector_type(2)));
typedef float f32x2 __attribute__((ext_vector_type(2)));
#define LAS __attribute__((address_space(3)))
typedef LAS unsigned char lds_u8;

constexpr int NB = 2, T = 8192, DM = 1024, M = NB * T, PC = 4896, NPAD = 5120, DFF = 4096;
constexpr int C_QA = 0, C_KA = 512, C_VA = 1024, C_QB = 1536, C_KC = 2048, C_VC = 2176, C_KS = 2304, C_VS = 2432, C_KW = 2560, C_VW = 2688,
              C_GA = 2816, C_GB = 3840, C_F = 4864, C_G3 = 4872;
constexpr float LOG2E = 1.4426950408889634f, QSCALE = 0.125f * LOG2E, RMS_EPS = 1e-6f;
constexpr size_t MiB = 1u << 20;
constexpr size_t WS_KNT = 2 * MiB + 64 * 1024;
constexpr size_t WS_TOT = WS_KNT + 8192;
constexpr size_t WS_BAR = 2 * MiB + 512 * 1024;
constexpr size_t WS_PART = 0, WS_CUM = 1 * MiB, WS_KC = WS_CUM + 512 * 1024, WS_PB1 = 2 * MiB;
constexpr size_t WS_WIN = 3 * MiB, WS_WOF = 13 * MiB, WS_WON = 14 * MiB, WS_WOUT = 15 * MiB, WS_WUP = 17 * MiB, WS_WDN = 25 * MiB, WS_WC1 = 33 * MiB, WS_WC2 = 35 * MiB;
constexpr size_t WS_PROJ = 36 * MiB, WS_XB = 190 * MiB, WS_OA = 190 * MiB, WS_ON = 206 * MiB, WS_MIX = 222 * MiB;
constexpr int LDS_BYTES = 135168;
constexpr int REP_FOX = 1, REP_NSA = 1, REP_G1 = 1, REP_G5 = 1, REP_W = 1, REP_SEL = 1, REP_TOPK = 1, REP_CMP = 1, REP_G23 = 1;

struct Params { const float* in[16]; float* out; unsigned char* ws; };
typedef const __attribute__((address_space(4))) Params* KParams;

__device__ __forceinline__ unsigned pk2(float lo, float hi) {
    typedef float f2 __attribute__((ext_vector_type(2))); typedef __bf16 b2 __attribute__((ext_vector_type(2)));
    f2 v = {lo, hi}; b2 b = __builtin_convertvector(v, b2); return __builtin_bit_cast(unsigned, b);
}
__device__ __forceinline__ float bf2f(unsigned short h) { return __uint_as_float(((unsigned)h) << 16); }
__device__ __forceinline__ float bflo(unsigned w) { return __uint_as_float(w << 16); }
__device__ __forceinline__ float bfhi(unsigned w) { return __uint_as_float(w & 0xffff0000u); }
__device__ __forceinline__ float wave_sum(float v) {
#pragma unroll
    for (int o = 32; o >= 1; o >>= 1) v += __shfl_xor(v, o);
    return v;
}
__device__ __forceinline__ float sigmoidf_(float z) { return 1.0f / (1.0f + __expf(-z)); }
__device__ __forceinline__ float row_rstd(const float* part, int row) {
    const f32x4* p = (const f32x4*)(part + (size_t)row * 16);
    f32x4 a = p[0], b = p[1], c = p[2], d = p[3];
    float s = ((a[0] + a[1]) + (a[2] + a[3])) + ((b[0] + b[1]) + (b[2] + b[3])) + ((c[0] + c[1]) + (c[2] + c[3])) + ((d[0] + d[1]) + (d[2] + d[3]));
    return rsqrtf(s * (1.0f / 1024.0f) + RMS_EPS);
}
__device__ __forceinline__ int src_col(int n) {
    if (n < 1536) return n;
    if (n < 2816) return n + 8;
    if (n < 4864) return n + 32;
    if (n < 4872) return n - 4864 + 1536;
    return n - 4872 + 2824;
}
__device__ __forceinline__ void rope_cs(int pos, int i, float& cs, float& sn) {
    const float inv = exp2f(-(float)i * (18.931568569324174f / 8.0f));
    const float ang = (float)pos * inv;
    const float k = rintf(ang * 0.15915494309189535f);
    float r = fmaf(-k, 6.2831854820251465f, ang); r = fmaf(-k, -1.7484555e-7f, r);
    cs = __cosf(r); sn = __sinf(r);
}

__device__ __forceinline__ int vt_pos(int kv) { const int q = (kv >> 2) & 3; return (kv & ~12) | ((((q == 1) ? 2 : (q == 2) ? 1 : q)) << 2); }
template <int ACT  > struct EpiScaleBf16 {
    static constexpr bool PERM = true, AFTER_DRAIN = false; static constexpr int MID_T = -1;
    bf16_t* O; int ldc; int ncols; const float* part;
    __device__ __forceinline__ void operator()(const f32x4 (&acc)[2][2][4][2], const pg8::Unit& u, int wr, int wc, int fr, int fq) const {
#pragma unroll
        for (int ai = 0; ai < 2; ++ai)
#pragma unroll
            for (int m = 0; m < 4; ++m) {
                const int row = u.pm * 256 + ai * 128 + wr * 64 + m * 16 + fr;
                const float rs = row_rstd(part, row);
#pragma unroll
                for (int bj = 0; bj < 2; ++bj) {
                    const int colb = u.pn * 256 + bj * 128, col = colb + wc * 32 + 8 * fq;
                    if (col < ncols) {
                        f32x4 v0 = acc[ai][bj][m][0] * rs, v1 = acc[ai][bj][m][1] * rs;
                        if (ACT == 1) {
#pragma unroll
                            for (int e = 0; e < 4; ++e) { float a = fmaxf(v0[e], 0.f), b = fmaxf(v1[e], 0.f); v0[e] = a * a; v1[e] = b * b; }
                        }
                        u32x4 w; w.x = pk2(v0[0], v0[1]); w.y = pk2(v0[2], v0[3]); w.z = pk2(v1[0], v1[1]); w.w = pk2(v1[2], v1[3]);
                        const bool vt = (ACT == 0) && ((colb >= C_VA && colb < C_VA + 512) || colb == C_VS || colb == C_VW);
                        if (vt) {
                            unsigned short* tp = O + (size_t)((row & ~63) + (col & 63)) * ldc + (col & ~63) + vt_pos(row & 63);
                            tp[0] = (unsigned short)(w.x & 0xffffu); tp[(size_t)1 * ldc] = (unsigned short)(w.x >> 16); tp[(size_t)2 * ldc] = (unsigned short)(w.y & 0xffffu); tp[(size_t)3 * ldc] = (unsigned short)(w.y >> 16);
                            tp[(size_t)4 * ldc] = (unsigned short)(w.z & 0xffffu); tp[(size_t)5 * ldc] = (unsigned short)(w.z >> 16); tp[(size_t)6 * ldc] = (unsigned short)(w.w & 0xffffu); tp[(size_t)7 * ldc] = (unsigned short)(w.w >> 16);
                        } else *(u32x4*)(O + (size_t)row * ldc + col) = w;
                    }
                }
                if (m & 1) asm volatile("" ::: "memory");
            }
    }
};
template <bool FIRST> struct EpiGateMix {
    static constexpr bool PERM = false, AFTER_DRAIN = false; static constexpr int MID_T = -1;
    bf16_t* mix; const bf16_t* proj; int gcol0;
    __device__ __forceinline__ void operator()(const f32x4 (&acc)[2][2][4][2], const pg8::Unit& u, int wr, int wc, int fr, int fq) const {
#pragma unroll
        for (int ai = 0; ai < 2; ++ai)
#pragma unroll
            for (int m = 0; m < 4; ++m) {
                const int row = u.pm * 256 + ai * 128 + wr * 64 + m * 16 + fr;
#pragma unroll
                for (int bj = 0; bj < 2; ++bj)
#pragma unroll
                    for (int n = 0; n < 2; ++n) {
                        const int col = u.pn * 256 + bj * 128 + wc * 32 + 16 * n + 4 * fq;
                        const u32x2 g = *(const u32x2*)(proj + (size_t)row * PC + gcol0 + col);
                        const f32x4 a = acc[ai][bj][m][n];
                        float r0 = sigmoidf_(bflo(g.x)) * a[0], r1 = sigmoidf_(bfhi(g.x)) * a[1], r2 = sigmoidf_(bflo(g.y)) * a[2], r3 = sigmoidf_(bfhi(g.y)) * a[3];
                        bf16_t* mp = mix + (size_t)row * DM + col;
                        if (!FIRST) { const u32x2 o = *(const u32x2*)mp; r0 += bflo(o.x); r1 += bfhi(o.x); r2 += bflo(o.y); r3 += bfhi(o.y); }
                        u32x2 w; w.x = pk2(r0, r1); w.y = pk2(r2, r3); *(u32x2*)mp = w;
                    }
                asm volatile("" ::: "memory");
            }
    }
};
struct EpiGateFused {
    static constexpr bool PERM = false, AFTER_DRAIN = false; static constexpr int MID_T = 8;
    bf16_t* mix; const bf16_t* proj;
    __device__ __forceinline__ static float eneg(float g) { return fminf(__expf(-g), 1e30f); }
    __device__ __forceinline__ void mid(f32x4 (&acc)[2][2][4][2], const pg8::Unit& u, int wr, int wc, int fr, int fq) const {
#pragma unroll
        for (int ai = 0; ai < 2; ++ai)
#pragma unroll
            for (int m = 0; m < 4; ++m) {
                int row = u.pm * 256 + ai * 128 + wr * 64 + m * 16 + fr; asm volatile("" : "+v"(row));
#pragma unroll
                for (int bj = 0; bj < 2; ++bj)
#pragma unroll
                    for (int n = 0; n < 2; ++n) {
                        const int col = u.pn * 256 + bj * 128 + wc * 32 + 16 * n + 4 * fq;
                        const unsigned go = (unsigned)row * (unsigned)PC + (unsigned)col;
                        const u32x2 ga = *(const u32x2*)(proj + C_GA + go), gb = *(const u32x2*)(proj + C_GB + go);
                        f32x4 a = acc[ai][bj][m][n];
                        a[0] *= (1.0f + eneg(bflo(gb.x))) * __builtin_amdgcn_rcpf(1.0f + eneg(bflo(ga.x))); a[1] *= (1.0f + eneg(bfhi(gb.x))) * __builtin_amdgcn_rcpf(1.0f + eneg(bfhi(ga.x)));
                        a[2] *= (1.0f + eneg(bflo(gb.y))) * __builtin_amdgcn_rcpf(1.0f + eneg(bflo(ga.y))); a[3] *= (1.0f + eneg(bfhi(gb.y))) * __builtin_amdgcn_rcpf(1.0f + eneg(bfhi(ga.y)));
                        acc[ai][bj][m][n] = a;
                        asm volatile("" : "+v"(acc[ai][bj][m][n]) :: "memory");
                    }
            }
    }
    __device__ __forceinline__ void operator()(const f32x4 (&acc)[2][2][4][2], const pg8::Unit& u, int wr, int wc, int fr, int fq) const {
#pragma unroll
        for (int ai = 0; ai < 2; ++ai)
#pragma unroll
            for (int m = 0; m < 4; ++m) {
                int row = u.pm * 256 + ai * 128 + wr * 64 + m * 16 + fr; asm volatile("" : "+v"(row));
#pragma unroll
                for (int bj = 0; bj < 2; ++bj)
#pragma unroll
                    for (int n = 0; n < 2; ++n) {
                        const int col = u.pn * 256 + bj * 128 + wc * 32 + 16 * n + 4 * fq;
                        const u32x2 gb = *(const u32x2*)(proj + C_GB + (unsigned)row * (unsigned)PC + (unsigned)col);
                        const f32x4 a = acc[ai][bj][m][n];
                        const float r0 = a[0] * __builtin_amdgcn_rcpf(1.0f + eneg(bflo(gb.x))), r1 = a[1] * __builtin_amdgcn_rcpf(1.0f + eneg(bfhi(gb.x)));
                        const float r2 = a[2] * __builtin_amdgcn_rcpf(1.0f + eneg(bflo(gb.y))), r3 = a[3] * __builtin_amdgcn_rcpf(1.0f + eneg(bfhi(gb.y)));
                        u32x2 w; w.x = pk2(r0, r1); w.y = pk2(r2, r3); *(u32x2*)(mix + ((unsigned)row * (unsigned)DM + (unsigned)col)) = w;
                    }
                if (m & 1) asm volatile("" ::: "memory");
            }
    }
};
struct EpiResidual {
    static constexpr bool PERM = false, AFTER_DRAIN = false; static constexpr int MID_T = -1;
    const float* xi; float* xo; bf16_t* xb; float* part; bool wxb;
    __device__ __forceinline__ void operator()(const f32x4 (&acc)[2][2][4][2], const pg8::Unit& u, int wr, int wc, int fr, int fq) const {
#pragma unroll
        for (int ai = 0; ai < 2; ++ai)
#pragma unroll
            for (int m = 0; m < 4; ++m) {
                const int row = u.pm * 256 + ai * 128 + wr * 64 + m * 16 + fr;
                float ss = 0.f;
#pragma unroll
                for (int bj = 0; bj < 2; ++bj)
#pragma unroll
                    for (int n = 0; n < 2; ++n) {
                        const int col = u.pn * 256 + bj * 128 + wc * 32 + 16 * n + 4 * fq;
                        const size_t off = (size_t)row * DM + col;
                        f32x4 v = *(const f32x4*)(xi + off) + acc[ai][bj][m][n];
                        *(f32x4*)(xo + off) = v;
                        if (wxb) { u32x2 w; w.x = pk2(v[0], v[1]); w.y = pk2(v[2], v[3]); *(u32x2*)(xb + off) = w; }
                        ss += (v[0] * v[0] + v[1] * v[1]) + (v[2] * v[2] + v[3] * v[3]);
                    }
                ss += __shfl_xor(ss, 16); ss += __shfl_xor(ss, 32);
                if (fq == 0) part[(size_t)row * 16 + u.pn * 4 + wc] = ss;
                asm volatile("" ::: "memory");
            }
    }
};

struct WTile { const float* W; bf16_t* WT; const float* rs; int K, Nsrc, Ndst, ldk, koff, mode, kt, nt; };
constexpr int W_NTILES = 1032;
__device__ __forceinline__ WTile wtile_decode(KParams P, int layer, int g) {
    unsigned char* ws = P->ws;
    WTile t; int base;
    if (g < 320)       { base = 0;    t.W = P->in[2] + (size_t)layer * DM * PC;   t.WT = (bf16_t*)(ws + WS_WIN);  t.rs = P->in[1] + layer * DM;  t.K = DM;   t.Nsrc = PC;  t.Ndst = PC;  t.ldk = DM;   t.koff = 0;   t.mode = 1; }
    else if (g < 576)  { base = 320;  t.W = P->in[13] + (size_t)layer * DM * DFF; t.WT = (bf16_t*)(ws + WS_WUP);  t.rs = P->in[12] + layer * DM; t.K = DM;   t.Nsrc = DFF; t.Ndst = DFF; t.ldk = DM;   t.koff = 0;   t.mode = 0; }
    else if (g < 832)  { base = 576;  t.W = P->in[14] + (size_t)layer * DFF * DM; t.WT = (bf16_t*)(ws + WS_WDN);  t.rs = nullptr;                t.K = DFF;  t.Nsrc = DM;  t.Ndst = DM;  t.ldk = DFF;  t.koff = 0;   t.mode = 0; }
    else if (g < 896)  { base = 832;  t.W = P->in[11] + (size_t)layer * DM * DM;  t.WT = (bf16_t*)(ws + WS_WOUT); t.rs = nullptr;                t.K = DM;   t.Nsrc = DM;  t.Ndst = DM;  t.ldk = DM;   t.koff = 0;   t.mode = 0; }
    else if (g < 928)  { base = 896;  t.W = P->in[9] + (size_t)layer * 512 * DM;  t.WT = (bf16_t*)(ws + WS_WOF);  t.rs = nullptr;                t.K = 512;  t.Nsrc = DM;  t.Ndst = DM;  t.ldk = 1024; t.koff = 0;   t.mode = 0; }
    else if (g < 960)  { base = 928;  t.W = P->in[10] + (size_t)layer * 512 * DM; t.WT = (bf16_t*)(ws + WS_WOF);  t.rs = nullptr;                t.K = 512;  t.Nsrc = DM;  t.Ndst = DM;  t.ldk = 1024; t.koff = 512; t.mode = 0; }
    else if (g < 1024) { const int kv = (g - 960) >> 5; base = 960 + 32 * kv;  t.W = P->in[5] + (size_t)(layer * 2 + kv) * 2048 * 256; t.WT = (bf16_t*)(ws + WS_WC1) + (size_t)kv * 256 * 2048; t.rs = nullptr; t.K = 2048; t.Nsrc = 256; t.Ndst = 256; t.ldk = 2048; t.koff = 0; t.mode = 0; }
    else               { const int kv = (g - 1024) >> 2; base = 1024 + 4 * kv; t.W = P->in[7] + (size_t)(layer * 2 + kv) * 256 * 64;   t.WT = (bf16_t*)(ws + WS_WC2) + (size_t)kv * 64 * 256;   t.rs = nullptr; t.K = 256;  t.Nsrc = 64;  t.Ndst = 64;  t.ldk = 256;  t.koff = 0; t.mode = 0; }
    const int tl = g - base, nkt = t.K >> 6;
    t.kt = tl % nkt; t.nt = tl / nkt;
    return t;
}
__device__ __forceinline__ void wtile_issue(const WTile& t, int tid, f32x4 (&v)[8], float (&rs)[8]) {
    const int c4 = tid & 63, r0 = tid >> 6, nd = t.nt * 256 + 4 * c4;
    const bool ok = nd < t.Ndst;
    const int ns = t.mode ? src_col(nd) : nd;
#pragma unroll
    for (int i = 0; i < 8; ++i) {
        const int k = t.kt * 64 + r0 + 8 * i;
        v[i] = ok ? *(const f32x4*)(t.W + (size_t)k * t.Nsrc + ns) : (f32x4){0.f, 0.f, 0.f, 0.f};
        rs[i] = t.rs ? t.rs[k] : 1.0f;
    }
}
__device__ __forceinline__ void wtile_finish(const WTile& t, int tid, lds_u8* sm, const f32x4 (&v)[8], const float (&rs)[8]) {
    LAS float* sT = (LAS float*)sm;
    const int c4 = tid & 63, r0 = tid >> 6, nd = t.nt * 256 + 4 * c4;
    const float cs = (t.mode && (nd < 512 || (nd >= 1536 && nd < 2048))) ? QSCALE : 1.0f;
#pragma unroll
    for (int i = 0; i < 8; ++i) *(LAS f32x4*)(sT + (r0 + 8 * i) * 260 + 4 * (c4 ^ i)) = v[i] * (rs[i] * cs);
    __syncthreads();
#pragma unroll
    for (int j = 0; j < 4; ++j) {
        const int p = tid + 512 * j, nl = p >> 3, c = p & 7, n2 = t.nt * 256 + nl;
        const LAS float* q = sT + (8 * c) * 260 + 4 * ((nl >> 2) ^ c) + (nl & 3);
        u32x4 w; w.x = pk2(q[0], q[260]); w.y = pk2(q[2 * 260], q[3 * 260]); w.z = pk2(q[4 * 260], q[5 * 260]); w.w = pk2(q[6 * 260], q[7 * 260]);
        if (n2 < t.Ndst) *(u32x4*)(t.WT + (size_t)n2 * t.ldk + t.koff + t.kt * 64 + 8 * c) = w;
    }
    __syncthreads();
}

__device__ __forceinline__ void phase_weights(KParams P, int layer, lds_u8* sm, int G, int bid, int tid) {
    unsigned char* ws = P->ws;
    {
        f32x4 va[8], vb[8]; float ra[8], rb[8];
        int g0 = bid;
        if (g0 < W_NTILES) {
            WTile t0 = wtile_decode(P, layer, g0);
            wtile_issue(t0, tid, va, ra);
            for (;;) {
                const int g1 = g0 + G; const bool has1 = g1 < W_NTILES;
                WTile t1 = wtile_decode(P, layer, has1 ? g1 : g0);
                if (has1) wtile_issue(t1, tid, vb, rb);
                wtile_finish(t0, tid, sm, va, ra);
                if (!has1) break;
                g0 = g1 + G; const bool has0 = g0 < W_NTILES;
                t0 = wtile_decode(P, layer, has0 ? g0 : g1);
                if (has0) wtile_issue(t0, tid, va, ra);
                wtile_finish(t1, tid, sm, vb, rb);
                if (!has0) break;
            }
        }
    }
    for (int wb = G - 1 - bid; wb < 32; wb += G) {
        const int kv = wb >> 4, ch = wb & 15, j = tid & 255, kh = tid >> 8;
        const float* w1 = P->in[5] + (size_t)(layer * 2 + kv) * 2048 * 256;
        const float* pos = P->in[4] + (size_t)(layer * 2 + kv) * 2048;
        float a = 0.f;
        {
            const int kb = ch * 128 + kh * 64;
#pragma unroll 1
            for (int k0 = 0; k0 < 64; k0 += 16) {
                float wv[16], pv[16];
#pragma unroll
                for (int i = 0; i < 16; ++i) { wv[i] = w1[(size_t)(kb + k0 + i) * 256 + j]; pv[i] = pos[kb + k0 + i]; }
#pragma unroll
                for (int i = 0; i < 16; ++i) a += pv[i] * wv[i];
            }
        }
        LAS float* red = (LAS float*)sm;
        if (kh == 1) red[j] = a;
        __syncthreads();
        if (kh == 0) ((float*)(ws + WS_PB1))[(kv * 16 + ch) * 256 + j] = a + red[j];
        __syncthreads();
    }
}

__device__ __forceinline__ void phase_x_to_bf16(KParams P, int G, int bid, int wid, int lane) {
    const float* __restrict__ x = P->in[0]; bf16_t* __restrict__ XB = (bf16_t*)(P->ws + WS_XB); float* __restrict__ part = (float*)(P->ws + WS_PART);
    for (int row0 = bid * 8 + wid; row0 < M; row0 += 4 * G * 8) {
        f32x4 v[4][4];
#pragma unroll
        for (int k = 0; k < 4; ++k) {
            const int row = row0 + k * G * 8;
#pragma unroll
            for (int i = 0; i < 4; ++i) v[k][i] = (row < M) ? ((const f32x4*)(x + (size_t)row * DM))[lane + 64 * i] : (f32x4){0.f, 0.f, 0.f, 0.f};
        }
#pragma unroll
        for (int k = 0; k < 4; ++k) {
            const int row = row0 + k * G * 8;
            if (row < M) {
                float ss = 0.f;
#pragma unroll
                for (int i = 0; i < 4; ++i) {
                    const f32x4 t = v[k][i];
                    ss += (t[0] * t[0] + t[1] * t[1]) + (t[2] * t[2] + t[3] * t[3]);
                    u32x2 w; w.x = pk2(t[0], t[1]); w.y = pk2(t[2], t[3]);
                    *(u32x2*)(XB + (size_t)row * DM + 4 * (lane + 64 * i)) = w;
                }
                ss = wave_sum(ss);
                if (lane < 16) part[(size_t)row * 16 + lane] = (lane == 0) ? ss : 0.f;
            }
        }
    }
}

__device__ __forceinline__ void phase_prep(KParams P, int layer, lds_u8* sm, int G, int bid, int tid, int wid, int lane) {
    unsigned char* ws = P->ws;
    bf16_t* proj = (bf16_t*)(ws + WS_PROJ);
    for (int w = bid; w < 256; w += G) {
        const int bh = w >> 4, c = w & 15, b = bh >> 3, h = bh & 7, t = c * 512 + tid;
        const float z = bf2f(proj[(size_t)(b * T + t) * PC + C_F + h]) + P->in[3][layer * 8 + h];
        const float lf = fminf(z, 0.f) - log1pf(__expf(-fabsf(z)));
        LAS float* sc = (LAS float*)sm;
        sc[tid] = lf;
        __syncthreads();
        for (int o = 1; o < 512; o <<= 1) {
            float v = sc[tid]; if (tid >= o) v += sc[tid - o];
            __syncthreads(); sc[tid] = v; __syncthreads();
        }
        const float pfx = sc[tid] * LOG2E;
        ((float*)(ws + WS_CUM))[(size_t)bh * T + t] = pfx;
        if (tid == 511) ((float*)(ws + WS_TOT))[bh * 16 + c] = pfx;
        __syncthreads();
    }
    for (int item = bid * 8 + wid; item < 16 * 128; item += G * 8) {
        const int bh = item >> 7, jt = item & 127, b = bh >> 3, h = bh & 7;
        const u32x4* kp = (const u32x4*)(proj + (size_t)(b * T + 64 * jt + lane) * PC + C_KA + h * 64);
        float ss = 0.f;
#pragma unroll
        for (int c = 0; c < 8; ++c) { const u32x4 w = kp[c];
#pragma unroll
            for (int e = 0; e < 4; ++e) { const float lo = bflo(w[e]), hi2 = bfhi(w[e]); ss += lo * lo + hi2 * hi2; } }
#pragma unroll
        for (int o = 32; o >= 1; o >>= 1) ss = fmaxf(ss, __shfl_xor(ss, o));
        if (lane == 0) ((float*)(ws + WS_KNT))[item] = sqrtf(ss) * 1.0001f;
    }
    for (int idx = bid * 512 + tid; idx < M * 12; idx += G * 512) {
        const int row = idx / 12, hh = idx - row * 12, pos = row & (T - 1);
        const int col = hh < 8 ? C_QB + hh * 64 : (hh < 10 ? C_KS + (hh - 8) * 64 : C_KW + (hh - 10) * 64);
        u32x4* p = (u32x4*)(proj + (size_t)row * PC + col);
        const u32x4 a = p[0], b = p[1];
        u32x4 oa, ob;
#pragma unroll
        for (int w = 0; w < 4; ++w) {
            float cs0, sn0, cs1, sn1; rope_cs(pos, 2 * w, cs0, sn0); rope_cs(pos, 2 * w + 1, cs1, sn1);
            const float x10 = bflo(a[w]), x11 = bfhi(a[w]), x20 = bflo(b[w]), x21 = bfhi(b[w]);
            oa[w] = pk2(x10 * cs0 - x20 * sn0, x11 * cs1 - x21 * sn1);
            ob[w] = pk2(x20 * cs0 + x10 * sn0, x21 * cs1 + x11 * sn1);
        }
        p[0] = oa; p[1] = ob;
    }
    for (int u = bid; u < 256; u += G) {
        const int kv = u >> 7, bg = (u >> 5) & 3, rt = u & 31, b = bg >> 1, g = bg & 1;
        const int col0 = (kv ? C_VC : C_KC) + g * 64, fr = lane & 15, kq = lane >> 4;
        int nld = rt * 16 + fr; if (nld > 510) nld = 510;
        const bf16_t* Ab = proj + (size_t)(b * T + 16 * nld) * PC + col0;
        const bf16_t* Bb = (const bf16_t*)(ws + WS_WC1) + (size_t)kv * 256 * 2048 + (size_t)fr * 2048;
        f32x4 acc[16];
#pragma unroll
        for (int j = 0; j < 16; ++j) acc[j] = (f32x4){0.f, 0.f, 0.f, 0.f};
#pragma unroll 1
        for (int ks = 0; ks < 8; ++ks) {
            const int k0 = 256 * wid + 32 * ks, l = k0 >> 6, d0 = (k0 & 63) + 8 * kq;
            const bf16x8 a = *(const bf16x8*)(Ab + (size_t)l * PC + d0);
#pragma unroll
            for (int jt = 0; jt < 16; ++jt) {
                const bf16x8 bb = *(const bf16x8*)(Bb + (size_t)jt * 16 * 2048 + k0 + 8 * kq);
                acc[jt] = __builtin_amdgcn_mfma_f32_16x16x32_bf16(a, bb, acc[jt], 0, 0, 0);
                if ((jt & 7) == 7) asm volatile("" ::: "memory");
            }
        }
        LAS float* red = (LAS float*)sm;
#pragma unroll 1
        for (int w = 0; w < 8; ++w) {
            if (wid == w) {
#pragma unroll
                for (int jt = 0; jt < 16; ++jt)
#pragma unroll
                    for (int r = 0; r < 4; ++r) { const int ix = (4 * kq + r) * 256 + 16 * jt + fr; if (w == 0) red[ix] = acc[jt][r]; else red[ix] += acc[jt][r]; }
            }
            __syncthreads();
        }
        LAS bf16_t* hid = (LAS bf16_t*)(sm + 16384);
        LAS float* outb = (LAS float*)(sm + 16384 + 8448);
        {
            const int j = tid & 255;
            const float* pb1 = (const float*)(ws + WS_PB1) + kv * 16 * 256 + j;
            float bias = P->in[6][(layer * 2 + kv) * 256 + j];
#pragma unroll
            for (int c = 0; c < 16; ++c) bias += pb1[c * 256];
#pragma unroll
            for (int i = 0; i < 8; ++i) {
                const int e = tid + 512 * i, row = e >> 8;
                const float x = red[e] + bias;
                const float uu = 0.7978845608028654f * (x + 0.044715f * x * x * x);
                const float th = 1.0f - 2.0f / (__expf(2.0f * uu) + 1.0f);
                const float gl = 0.5f * x * (1.0f + th);
                hid[row * 264 + j] = (bf16_t)(pk2(gl, 0.f) & 0xffffu);
            }
        }
        __syncthreads();
        if (wid < 4) {
            f32x4 a2 = (f32x4){0.f, 0.f, 0.f, 0.f};
            const bf16_t* B2 = (const bf16_t*)(ws + WS_WC2) + (size_t)kv * 64 * 256 + (size_t)(16 * wid + fr) * 256;
#pragma unroll
            for (int ks = 0; ks < 8; ++ks) {
                const bf16x8 a = *(const LAS bf16x8*)(hid + fr * 264 + 32 * ks + 8 * kq);
                const bf16x8 bb = *(const bf16x8*)(B2 + 32 * ks + 8 * kq);
                a2 = __builtin_amdgcn_mfma_f32_16x16x32_bf16(a, bb, a2, 0, 0, 0);
            }
            const float b2 = P->in[8][(layer * 2 + kv) * 64 + 16 * wid + fr];
#pragma unroll
            for (int r = 0; r < 4; ++r) outb[(4 * kq + r) * 64 + 16 * wid + fr] = a2[r] + b2;
        }
        __syncthreads();
        bf16_t* KCV = (bf16_t*)(ws + WS_KC) + (size_t)(kv * 4 + bg) * 512 * 64;
#pragma unroll
        for (int i = 0; i < 2; ++i) {
            const int e = tid + 512 * i, row = e >> 6, c = e & 63, n = rt * 16 + row;
            float v = outb[e];
            if (kv == 0 && c < 16) {
                const int i8 = c & 7; const float x1 = outb[row * 64 + i8], x2 = outb[row * 64 + 8 + i8];
                float cs, sn; rope_cs(16 * n + 31, i8, cs, sn);
                v = c < 8 ? x1 * cs - x2 * sn : x2 * cs + x1 * sn;
            }
            if (n >= 511) v = 0.f;
            if (kv == 0) KCV[(size_t)n * 64 + c] = (bf16_t)(pk2(v, 0.f) & 0xffffu);
            else KCV[(size_t)(n >> 6) * 4096 + c * 64 + vt_pos(n & 63)] = (bf16_t)(pk2(v, 0.f) & 0xffffu);
        }
        __syncthreads();
    }
}

constexpr int A_STAGE = 18688  , A_IMP = 3 * A_STAGE, A_OPART = A_IMP  , A_SELM = A_IMP + 65536, A_TL = A_SELM + 1024, A_END = A_TL + 528;
static_assert(A_END + 64 <= 131072 && 64 * 129 * 4 <= 65536, "attention LDS map");
struct FS { f32x16 o0, o1; float m, l; };
__device__ __forceinline__ void fs_init(FS& s) {
#pragma unroll
    for (int r = 0; r < 16; ++r) { s.o0[r] = 0.f; s.o1[r] = 0.f; }
    s.m = -1e30f; s.l = 0.f;
}
struct MaskCtx { int qpos; int diag0; int cur; unsigned mw0, mw1, mw2, mw3; };

__device__ __forceinline__ float xhalf_max(float v) { auto rr = __builtin_amdgcn_permlane32_swap(__float_as_uint(v), __float_as_uint(v), false, false); return fmaxf(__uint_as_float(rr[0]), __uint_as_float(rr[1])); }
__device__ __forceinline__ float xhalf_sum(float v) { auto rr = __builtin_amdgcn_permlane32_swap(__float_as_uint(v), __float_as_uint(v), false, false); return __uint_as_float(rr[0]) + __uint_as_float(rr[1]); }

#define LDS_BARRIER() asm volatile("s_waitcnt lgkmcnt(0)\n\ts_barrier" ::: "memory")
__device__ __forceinline__ float quad_sum(float v) {
    v += __uint_as_float((unsigned)__builtin_amdgcn_update_dpp(0, (int)__float_as_uint(v), 0xB1, 0xF, 0xF, false));
    v += __uint_as_float((unsigned)__builtin_amdgcn_update_dpp(0, (int)__float_as_uint(v), 0x4E, 0xF, 0xF, false));
    return v;
}
__device__ __forceinline__ int oct_sum(int v) {
    v += __builtin_amdgcn_update_dpp(0, v, 0xB1, 0xF, 0xF, false);
    v += __builtin_amdgcn_update_dpp(0, v, 0x4E, 0xF, 0xF, false);
    v += __builtin_amdgcn_update_dpp(0, v, 0x141, 0xF, 0xF, false);
    return v;
}
template <int MODE, int PASS>
__device__ __forceinline__ void flash_run(lds_u8* sm, const bf16_t* __restrict__ Kg, const bf16_t* __restrict__ Vg, int pitch, int first, int nt, bool uselist, const LAS int* list,
                                          const float* __restrict__ cum, float cref, const bf16x8 (&qf)[4], FS& st, const MaskCtx& mc, int tid, int lane, int qloc) {
    if (nt <= 0) return;
    const int r32 = lane & 31, hi = lane >> 5;
    const int krow = tid >> 3, kch = tid & 7;
    u32x4 rkA, rvA, rkB, rvB; float rcA = 0.f, rcB = 0.f;
    float invl = 0.f;
    if (PASS == 2) invl = st.l > 0.f ? 1.0f / st.l : 0.f;
    auto tile_of = [&](int i) -> int { return uselist ? list[i] : first + i; };
    auto gload = [&](int jt, u32x4& rk, u32x4& rv, float& rc) {
        rk = *(const u32x4*)(Kg + (size_t)(64 * jt + krow) * pitch + kch * 8);
        if (PASS != 1) rv = *(const u32x4*)(Vg + (size_t)(64 * jt + krow) * pitch + kch * 8);
        if (MODE == 0) { if (tid < 64) rc = cref - (cum[64 * jt + tid] + ((const LAS float*)(sm + A_SELM))[16 + (jt >> 3)]); }
    };
    auto lstore = [&](int buf, const u32x4& rk, const u32x4& rv, float rc) {
        lds_u8* bb = sm + buf * A_STAGE;
        *(LAS u32x4*)(bb + krow * 144 + kch * 16) = rk;
        if (PASS != 1) *(LAS u32x4*)(bb + 9216 + krow * 144 + kch * 16) = rv;
        if (MODE == 0) {
            if (tid < 64) {
                const unsigned hb = pk2(rc, 0.f) & 0xffffu; const float lo = rc - bflo(hb);
                *(LAS u32x4*)(bb + tid * 144 + 128) = (u32x4){hb | (pk2(lo, 0.f) << 16), 0u, 0u, 0u};
            }
        }
    };
    f32x16 negm;
#pragma unroll
    for (int r = 0; r < 16; ++r) negm[r] = (PASS == 2) ? -st.m : 0.f;
    if (PASS != 2) st.m = 0.f;
    auto smm = [&](int buf, f32x16& d0, f32x16& d1) {
        const lds_u8* Ks = sm + buf * A_STAGE;
        bf16x8 kf[8];
#pragma unroll
        for (int s = 0; s < 4; ++s) {
            kf[2 * s]     = *(const LAS bf16x8*)(Ks + r32 * 144 + (16 * s + 8 * hi) * 2);
            kf[2 * s + 1] = *(const LAS bf16x8*)(Ks + (r32 + 32) * 144 + (16 * s + 8 * hi) * 2);
        }
        __builtin_amdgcn_sched_barrier(0);
        d0 = __builtin_amdgcn_mfma_f32_32x32x16_bf16(kf[0], qf[0], negm, 0, 0, 0); d1 = __builtin_amdgcn_mfma_f32_32x32x16_bf16(kf[1], qf[0], negm, 0, 0, 0);
#pragma unroll
        for (int s = 1; s < 4; ++s) { d0 = __builtin_amdgcn_mfma_f32_32x32x16_bf16(kf[2 * s], qf[s], d0, 0, 0, 0); d1 = __builtin_amdgcn_mfma_f32_32x32x16_bf16(kf[2 * s + 1], qf[s], d1, 0, 0, 0); }
        if (MODE == 0) {
            const bf16x8 b0 = *(const LAS bf16x8*)(Ks + r32 * 144 + 128 + 16 * hi), b1 = *(const LAS bf16x8*)(Ks + (r32 + 32) * 144 + 128 + 16 * hi);
            const short one = hi ? (short)0 : (short)0x3F80;
            const bf16x8 qb1 = (bf16x8){one, one, 0, 0, 0, 0, 0, 0};
            d0 = __builtin_amdgcn_mfma_f32_32x32x16_bf16(b0, qb1, d0, 0, 0, 0); d1 = __builtin_amdgcn_mfma_f32_32x32x16_bf16(b1, qb1, d1, 0, 0, 0);
        }
        __builtin_amdgcn_sched_barrier(0);
    };
    auto softpv = [&](int jt, int buf, f32x16& p0, f32x16& p1, f32x16& pn0, f32x16& pn1, bool has_next) {
        const lds_u8* Vt = sm + buf * A_STAGE + 9216;
        const LAS float* cb = (const LAS float*)(sm + buf * A_STAGE + 18432);
        const float NEG = -INFINITY;
        bool selbit = true;
        if (MODE == 2) { const unsigned w = ((const LAS unsigned*)(sm + A_SELM))[qloc * 4 + (jt >> 5)]; selbit = (w >> (jt & 31)) & 1u; }
        bool need = false;
        if (MODE == 0) need = jt >= mc.diag0;
        if (MODE == 1) need = 16 * (64 * jt + 63) + 31 > mc.diag0;
        if (MODE == 2) need = jt == mc.cur;
        if (MODE == 3) need = (jt == mc.cur) || (jt + 8 == mc.cur);
        if (need) {
#pragma unroll
            for (int r = 0; r < 16; ++r) {
                const int kl = (r & 3) + 8 * (r >> 2) + 4 * hi, k0 = 64 * jt + kl, k1 = k0 + 32;
                float s0 = p0[r], s1 = p1[r];
                if (MODE == 0 || MODE == 2) { if (k0 > mc.qpos) s0 = NEG; if (k1 > mc.qpos) s1 = NEG; }
                if (MODE == 1) { if (16 * k0 + 31 > mc.qpos) s0 = NEG; if (16 * k1 + 31 > mc.qpos) s1 = NEG; }
                if (MODE == 3) { if (k0 > mc.qpos || mc.qpos - k0 >= 512) s0 = NEG; if (k1 > mc.qpos || mc.qpos - k1 >= 512) s1 = NEG; }
                p0[r] = s0; p1[r] = s1;
            }
        }
        if (PASS != 2) {
            float m0 = __builtin_fmaxf(__builtin_fmaxf(p0[0], p0[1]), p0[2]), m1 = __builtin_fmaxf(__builtin_fmaxf(p1[0], p1[1]), p1[2]);
#pragma unroll
            for (int r = 3; r < 15; r += 2) { m0 = __builtin_fmaxf(__builtin_fmaxf(m0, p0[r]), p0[r + 1]); m1 = __builtin_fmaxf(__builtin_fmaxf(m1, p1[r]), p1[r + 1]); }
            float mx = __builtin_fmaxf(__builtin_fmaxf(m0, m1), __builtin_fmaxf(p0[15], p1[15]));
            mx = xhalf_max(mx);
            if (MODE == 2) mx = selbit ? mx : NEG;
            if (__any(mx > 8.0f)) {
                const float d = fmaxf(mx, 0.f), al = __builtin_amdgcn_exp2f(-d);
                st.m += d; st.l *= al;
#pragma unroll
                for (int r = 0; r < 16; ++r) { p0[r] -= d; p1[r] -= d; negm[r] -= d; }
                if (has_next) {
#pragma unroll
                    for (int r = 0; r < 16; ++r) { pn0[r] -= d; pn1[r] -= d; }
                }
                if (PASS == 0) {
#pragma unroll
                    for (int r = 0; r < 16; ++r) { st.o0[r] *= al; st.o1[r] *= al; }
                }
            }
            f32x2 acc2 = {0.f, 0.f};
#pragma unroll
            for (int r = 0; r < 16; r += 2) {
                p0[r] = __builtin_amdgcn_exp2f(p0[r]); p0[r + 1] = __builtin_amdgcn_exp2f(p0[r + 1]); p1[r] = __builtin_amdgcn_exp2f(p1[r]); p1[r + 1] = __builtin_amdgcn_exp2f(p1[r + 1]);
                acc2 += (f32x2){p0[r], p0[r + 1]}; acc2 += (f32x2){p1[r], p1[r + 1]};
            }
            float sum = xhalf_sum(acc2.x + acc2.y);
            if (MODE == 2) sum = selbit ? sum : 0.f;
            st.l += sum;
        } else {
#pragma unroll
            for (int r = 0; r < 16; ++r) { p0[r] = __builtin_amdgcn_exp2f(p0[r]) * invl; p1[r] = __builtin_amdgcn_exp2f(p1[r]) * invl; }
            float A[8], H[8];
#pragma unroll
            for (int g8 = 0; g8 < 8; ++g8) {
                const int hf = g8 >> 2, u4 = g8 & 3;
                const float x0 = hf ? p1[4 * u4] : p0[4 * u4], x1 = hf ? p1[4 * u4 + 1] : p0[4 * u4 + 1], x2 = hf ? p1[4 * u4 + 2] : p0[4 * u4 + 2], x3 = hf ? p1[4 * u4 + 3] : p0[4 * u4 + 3];
                A[g8] = quad_sum((x0 + x1) + (x2 + 0.5f * x3)); H[g8] = quad_sum(0.5f * x3);
            }
            float W[17];
#pragma unroll
            for (int g8 = 0; g8 < 8; ++g8) {
                const auto ra = __builtin_amdgcn_permlane32_swap(__float_as_uint(A[g8]), __float_as_uint(A[g8]), false, false);
                const auto rh = __builtin_amdgcn_permlane32_swap(__float_as_uint(H[g8]), __float_as_uint(H[g8]), false, false);
                const float a0 = __uint_as_float(ra[0]), a1 = __uint_as_float(ra[1]), h0 = __uint_as_float(rh[0]), h1 = __uint_as_float(rh[1]);
                if (g8 == 0) W[0] = a0; else W[2 * g8] += a0;
                W[2 * g8 + 1] = h0 + a1; W[2 * g8 + 2] = h1;
            }
            if ((lane & 35) == 0) {
                LAS float* imp = (LAS float*)(sm + A_IMP) + qloc * 129 + 16 * jt;
#pragma unroll
                for (int k = 0; k < 17; ++k) imp[k] += W[k];
            }
        }
        if (PASS != 1) {
            const unsigned pmask = (MODE == 2) ? (selbit ? 0xffffffffu : 0u) : 0xffffffffu;
            bf16x8 pb[4];
#pragma unroll
            for (int sp = 0; sp < 4; ++sp) {
                const int rb = (sp & 1) * 8;
                u32x4 pw;
                if (sp < 2) { pw.x = pk2(p0[rb], p0[rb + 1]); pw.y = pk2(p0[rb + 2], p0[rb + 3]); pw.z = pk2(p0[rb + 4], p0[rb + 5]); pw.w = pk2(p0[rb + 6], p0[rb + 7]); }
                else        { pw.x = pk2(p1[rb], p1[rb + 1]); pw.y = pk2(p1[rb + 2], p1[rb + 3]); pw.z = pk2(p1[rb + 4], p1[rb + 5]); pw.w = pk2(p1[rb + 6], p1[rb + 7]); }
                if (MODE == 2) { pw.x &= pmask; pw.y &= pmask; pw.z &= pmask; pw.w &= pmask; }
                pb[sp] = __builtin_bit_cast(bf16x8, pw);
            }
#pragma unroll
            for (int dh = 0; dh < 2; ++dh) {
                bf16x8 vf[4];
#pragma unroll
                for (int sp = 0; sp < 4; ++sp) {
                    const int kvb = (sp & 1) * 16 + (sp >> 1) * 32;
                    vf[sp] = *(const LAS bf16x8*)(Vt + (r32 + 32 * dh) * 144 + (kvb + 8 * hi) * 2);
                }
                __builtin_amdgcn_sched_barrier(0);
#pragma unroll
                for (int sp = 0; sp < 4; ++sp) {
                    if (dh == 0) st.o0 = __builtin_amdgcn_mfma_f32_32x32x16_bf16(vf[sp], pb[sp], st.o0, 0, 0, 0);
                    else         st.o1 = __builtin_amdgcn_mfma_f32_32x32x16_bf16(vf[sp], pb[sp], st.o1, 0, 0, 0);
                }
                __builtin_amdgcn_sched_barrier(0);
            }
        }
    };
    gload(tile_of(0), rkA, rvA, rcA);
    if (nt > 1) gload(tile_of(1), rkB, rvB, rcB);
    lstore(0, rkA, rvA, rcA);
    if (nt > 1) lstore(1, rkB, rvB, rcB);
    if (nt > 2) gload(tile_of(2), rkA, rvA, rcA);
    LDS_BARRIER();
    auto wave_active = [&](int jt) -> bool {
        if (MODE != 2) return true;
        const unsigned w = ((const LAS unsigned*)(sm + A_SELM))[qloc * 4 + (jt >> 5)];
        return __any((w >> (jt & 31)) & 1u) != 0;
    };
    f32x16 pa0, pa1;
    int b0 = 0;
    for (int i = 0; i < nt; i += 2) {
        int b1 = b0 + 1; if (b1 == 3) b1 = 0; int b2 = b1 + 1; if (b2 == 3) b2 = 0;
        if (i + 3 < nt) gload(tile_of(i + 3), rkB, rvB, rcB);
        if (wave_active(tile_of(i))) { smm(b0, pa0, pa1); softpv(tile_of(i), b0, pa0, pa1, pa0, pa1, false); }
        if (i + 2 < nt) lstore(b2, rkA, rvA, rcA);
        LDS_BARRIER();
        if (i + 1 >= nt) break;
        if (i + 4 < nt) gload(tile_of(i + 4), rkA, rvA, rcA);
        if (wave_active(tile_of(i + 1))) { smm(b1, pa0, pa1); softpv(tile_of(i + 1), b1, pa0, pa1, pa0, pa1, false); }
        if (i + 3 < nt) lstore(b0, rkB, rvB, rcB);
        LDS_BARRIER();
        b0 = b2;
    }
}

__device__ __forceinline__ void load_q(bf16x8 (&qf)[4], const bf16_t* qrow, int hi) {
#pragma unroll
    for (int s = 0; s < 4; ++s) qf[s] = *(const bf16x8*)(qrow + 16 * s + 8 * hi);
}
__device__ __forceinline__ void store_o(bf16_t* orow, const f32x16& v0, const f32x16& v1, int hi) {
#pragma unroll
    for (int g4 = 0; g4 < 4; ++g4) {
        u32x2 a, b; a.x = pk2(v0[4 * g4], v0[4 * g4 + 1]); a.y = pk2(v0[4 * g4 + 2], v0[4 * g4 + 3]); b.x = pk2(v1[4 * g4], v1[4 * g4 + 1]); b.y = pk2(v1[4 * g4 + 2], v1[4 * g4 + 3]);
        *(u32x2*)(orow + 8 * g4 + 4 * hi) = a; *(u32x2*)(orow + 32 + 8 * g4 + 4 * hi) = b;
    }
}

__device__ __forceinline__ void oacc_store(float* orow, const f32x16& v0, const f32x16& v1, int hi) {
#pragma unroll
    for (int g4 = 0; g4 < 4; ++g4) {
        *(f32x4*)(orow + 8 * g4 + 4 * hi) = (f32x4){v0[4 * g4], v0[4 * g4 + 1], v0[4 * g4 + 2], v0[4 * g4 + 3]};
        *(f32x4*)(orow + 32 + 8 * g4 + 4 * hi) = (f32x4){v1[4 * g4], v1[4 * g4 + 1], v1[4 * g4 + 2], v1[4 * g4 + 3]};
    }
}
__device__ __forceinline__ void oacc_add(const float* orow, f32x16& v0, f32x16& v1, int hi) {
#pragma unroll
    for (int g4 = 0; g4 < 4; ++g4) {
        const f32x4 a = *(const f32x4*)(orow + 8 * g4 + 4 * hi), b = *(const f32x4*)(orow + 32 + 8 * g4 + 4 * hi);
#pragma unroll
        for (int e = 0; e < 4; ++e) { v0[4 * g4 + e] += a[e]; v1[4 * g4 + e] += b[e]; }
    }
}

__device__ __forceinline__ void opart_store(lds_u8* sm, int tid, const f32x16& v0, const f32x16& v1) {
#pragma unroll
    for (int g4 = 0; g4 < 4; ++g4) {
        *(LAS f32x4*)(sm + A_OPART + (g4 * 512 + tid) * 16) = (f32x4){v0[4 * g4], v0[4 * g4 + 1], v0[4 * g4 + 2], v0[4 * g4 + 3]};
        *(LAS f32x4*)(sm + A_OPART + ((4 + g4) * 512 + tid) * 16) = (f32x4){v1[4 * g4], v1[4 * g4 + 1], v1[4 * g4 + 2], v1[4 * g4 + 3]};
    }
}
__device__ __forceinline__ void opart_add(const lds_u8* sm, int tid, f32x16& v0, f32x16& v1) {
#pragma unroll
    for (int g4 = 0; g4 < 4; ++g4) {
        const f32x4 a = *(const LAS f32x4*)(sm + A_OPART + (g4 * 512 + tid) * 16), b = *(const LAS f32x4*)(sm + A_OPART + ((4 + g4) * 512 + tid) * 16);
#pragma unroll
        for (int e = 0; e < 4; ++e) { v0[4 * g4 + e] += a[e]; v1[4 * g4 + e] += b[e]; }
    }
}

__device__ __forceinline__ void fox_unit(KParams P, lds_u8* sm, int bh0, int qb0, int tid0, int wid, int lane0) {
    int bh = bh0, qb = qb0; asm volatile("" : "+s"(bh), "+s"(qb));
    int tid = tid0; asm volatile("" : "+v"(tid)); const int lane = tid & 63;
    const bf16_t* proj = (const bf16_t*)(P->ws + WS_PROJ);
    const int b = bh >> 3, h = bh & 7, r32 = lane & 31, hi = lane >> 5;
    const int q = qb * 256 + 32 * wid + r32;
    bf16x8 qf[4]; load_q(qf, proj + (size_t)(b * T + q) * PC + C_QA + h * 64, hi);
    const float* cum = (const float*)(P->ws + WS_CUM) + (size_t)bh * T;
    const float* tot = (const float*)(P->ws + WS_TOT) + bh * 16;
    LAS float* offs = (LAS float*)(sm + A_SELM) + 16;
    if (tid < 16) {
        float tv[15];
#pragma unroll
        for (int c = 0; c < 15; ++c) tv[c] = tot[c];
        float o = 0.f;
#pragma unroll
        for (int c = 0; c < 15; ++c) o += (c < tid) ? tv[c] : 0.f;
        offs[tid] = o;
    }
    float offq = 0.f;
    {
        float tv[15];
#pragma unroll
        for (int c = 0; c < 15; ++c) tv[c] = tot[c];
#pragma unroll
        for (int c = 0; c < 15; ++c) offq += (c < (qb >> 1)) ? tv[c] : 0.f;
    }
    const float cref = cum[qb * 256] + offq;
    FS st; fs_init(st);
    MaskCtx mc; mc.qpos = q; mc.diag0 = 4 * qb; mc.cur = 0; mc.mw0 = mc.mw1 = mc.mw2 = mc.mw3 = 0u;
    {
        bf16x8 kf[4]; load_q(kf, proj + (size_t)(b * T + q) * PC + C_KA + h * 64, hi);
        float qq = 0.f, qk = 0.f;
#pragma unroll
        for (int s4 = 0; s4 < 4; ++s4)
#pragma unroll
            for (int e = 0; e < 8; ++e) { const float a = bf2f((unsigned short)qf[s4][e]), kk = bf2f((unsigned short)kf[s4][e]); qq += a * a; qk += a * kk; }
        qq += __shfl_xor(qq, 32); qk += __shfl_xor(qk, 32);
        float qn = sqrtf(qq) * 1.0001f, bm = (cum[q] + offq) - qk;
#pragma unroll
        for (int o = 16; o >= 1; o >>= 1) { qn = fmaxf(qn, __shfl_xor(qn, o)); bm = fmaxf(bm, __shfl_xor(bm, o)); }
        LAS float* red = (LAS float*)(sm + A_SELM);
        if (lane == 0) { red[wid] = qn; red[8 + wid] = bm; }
        const float* knt = (const float*)(P->ws + WS_KNT) + bh * 128;
        float kn_pre[2] = {0.f, 0.f}, ce_pre[2] = {0.f, 0.f};
        if (wid == 0) {
#pragma unroll
            for (int hf = 0; hf < 2; ++hf) { kn_pre[hf] = knt[lane + 64 * hf]; ce_pre[hf] = cum[64 * (lane + 64 * hf) + 63]; }
        }
        __syncthreads();
        if (wid == 0) {
            float QN = red[0], BM = red[8];
#pragma unroll
            for (int w = 1; w < 8; ++w) { QN = fmaxf(QN, red[w]); BM = fmaxf(BM, red[8 + w]); }
            LAS int* tl = (LAS int*)(sm + A_TL);
            int base = 0;
#pragma unroll
            for (int hf = 0; hf < 2; ++hf) {
                const int jt = lane + 64 * hf;
                bool keep = false;
                if (jt < 4 * qb) keep = !(QN * kn_pre[hf] + BM - (ce_pre[hf] + offs[jt >> 3]) < -48.0f);
                else if (jt < 4 * qb + 4) keep = true;
                const unsigned long long mk = __ballot(keep);
                if (keep) tl[1 + base + __popcll(mk & ((1ull << lane) - 1ull))] = jt;
                base += __popcll(mk);
            }
            if (lane == 0) tl[0] = base;
        }
        __syncthreads();
    }
    {
        const LAS int* tl = (const LAS int*)(sm + A_TL);
        flash_run<0, 0>(sm, proj + (size_t)(b * T) * PC + C_KA + h * 64, proj + (size_t)(b * T) * PC + C_VA + h * 64, PC, 0, tl[0], true, tl + 1, cum, cref, qf, st, mc, tid, lane, 0);
    }
    const float il = st.l > 0.f ? 1.0f / st.l : 0.f;
    st.o0 *= il; st.o1 *= il;
    store_o((bf16_t*)(P->ws + WS_OA) + (size_t)(b * T + q) * 1024 + h * 64, st.o0, st.o1, hi);
}

__device__ __forceinline__ void nsa_unit(KParams P, lds_u8* sm, int bg0, int qt0, int tid0, int wid, int lane0) {
    int bg = bg0, qt = qt0; asm volatile("" : "+s"(bg), "+s"(qt));
    int tid = tid0; asm volatile("" : "+v"(tid)); const int lane = tid & 63;
    const bf16_t* proj = (const bf16_t*)(P->ws + WS_PROJ);
    const int b = bg >> 1, g = bg & 1, r32 = lane & 31, hi = lane >> 5, head = r32 & 3, hq = g * 4 + head;
    const int qloc = 8 * wid + (r32 >> 2), q = qt * 64 + qloc;
    const size_t prow = (size_t)(b * T + q) * PC;
    bf16x8 qf[4]; load_q(qf, proj + prow + C_QB + hq * 64, hi);
#define NSA_GATE(br) sigmoidf_(bf2f(proj[(size_t)(b * T + q) * PC + C_G3 + hq * 3 + (br)]))
#define NSA_OACC ((float*)(P->ws + WS_MIX) + (size_t)(b * T + q) * 512 + hq * 64)
    MaskCtx mc; mc.qpos = q; mc.diag0 = qt * 64; mc.cur = qt; mc.mw0 = mc.mw1 = mc.mw2 = mc.mw3 = 0u;
    for (int e = tid; e < 64 * 129; e += 512) ((LAS float*)(sm + A_IMP))[e] = 0.f;
    if (tid < 256) ((LAS unsigned*)(sm + A_SELM))[tid] = 0u;
    __syncthreads();
    f32x16 oc0, oc1;
    {
        const bf16_t* KC = (const bf16_t*)(P->ws + WS_KC) + (size_t)(0 * 4 + bg) * 512 * 64;
        const bf16_t* VC = (const bf16_t*)(P->ws + WS_KC) + (size_t)(1 * 4 + bg) * 512 * 64;
        const int ntc = (4 * qt + 3 + 63) >> 6;
        FS st;
        int repc_ = REP_CMP; asm volatile("" : "+s"(repc_));
#pragma unroll 1
        for (int rc_ = 0; rc_ < repc_; ++rc_) {
        fs_init(st);
        flash_run<1, 1>(sm, KC, VC, 64, 0, ntc, false, (const LAS int*)(sm + A_TL), nullptr, 0.f, qf, st, mc, tid, lane, qloc);
        flash_run<1, 2>(sm, KC, VC, 64, 0, ntc, false, (const LAS int*)(sm + A_TL), nullptr, 0.f, qf, st, mc, tid, lane, qloc);
        }
        const float g0 = NSA_GATE(0); oc0 = st.o0 * g0; oc1 = st.o1 * g0;
    }
    { int reps_ = REP_TOPK; asm volatile("" : "+s"(reps_));
#pragma unroll 1
    for (int rep_ = 0; rep_ < reps_; ++rep_)
    {
        const int ql = tid >> 3, sub = tid & 7, cur = qt;
        const LAS float* imp = (const LAS float*)(sm + A_IMP) + ql * 129;
        unsigned vb[16];
#pragma unroll
        for (int i = 0; i < 16; ++i) { const int s = sub * 16 + i; const float v = (s == 0 || s == cur) ? 1e6f : imp[s]; vb[i] = (s <= cur) ? __float_as_uint(v) : 0u; }
        unsigned bits = 0u;
        if (cur < 16) {
#pragma unroll
            for (int i = 0; i < 16; ++i) { if (sub * 16 + i <= cur) bits |= 1u << i; }
        } else {
            unsigned t = 0u;
            for (int bit = 30; bit >= 0; --bit) {
                const unsigned cand = t | (1u << bit);
                int c = 0;
#pragma unroll
                for (int i = 0; i < 16; ++i) c += (vb[i] >= cand) ? 1 : 0;
                c = oct_sum(c);
                if (c >= 16) t = cand;
            }
            int cg = 0, ce = 0;
#pragma unroll
            for (int i = 0; i < 16; ++i) { cg += (vb[i] > t) ? 1 : 0; ce += (vb[i] == t) ? 1 : 0; }
            const int need = 16 - oct_sum(cg);
            int pre = 0;
#pragma unroll
            for (int k = 0; k < 7; ++k) { const int ck = __shfl(ce, (lane & ~7) + k); pre += (k < sub) ? ck : 0; }
#pragma unroll
            for (int i = 0; i < 16; ++i) {
                const bool eq = vb[i] == t;
                if (sub * 16 + i <= cur && (vb[i] > t || (eq && pre < need))) bits |= 1u << i;
                pre += eq ? 1 : 0;
            }
        }
        if (bits) __hip_atomic_fetch_or((LAS unsigned*)(sm + A_SELM) + ql * 4 + (sub >> 1), bits << ((sub & 1) * 16), __ATOMIC_RELAXED, __HIP_MEMORY_SCOPE_WORKGROUP);
    }
    }
    __syncthreads();
    opart_store(sm, tid, oc0, oc1);
    {
        const LAS unsigned* selm = (const LAS unsigned*)(sm + A_SELM);
        mc.mw0 = selm[qloc * 4 + 0]; mc.mw1 = selm[qloc * 4 + 1]; mc.mw2 = selm[qloc * 4 + 2]; mc.mw3 = selm[qloc * 4 + 3];
        if (wid == 0) {
            unsigned u0 = selm[lane * 4 + 0], u1 = selm[lane * 4 + 1], u2 = selm[lane * 4 + 2], u3 = selm[lane * 4 + 3];
#pragma unroll
            for (int o = 32; o >= 1; o >>= 1) { u0 |= __shfl_xor(u0, o); u1 |= __shfl_xor(u1, o); u2 |= __shfl_xor(u2, o); u3 |= __shfl_xor(u3, o); }
            {
                LAS int* tl = (LAS int*)(sm + A_TL);
                const unsigned wlo = (lane < 32) ? u0 : u1, whi = (lane < 32) ? u2 : u3;
                const bool k0 = (wlo >> (lane & 31)) & 1u, k1 = (whi >> (lane & 31)) & 1u;
                const unsigned long long m0 = __ballot(k0), m1 = __ballot(k1);
                const unsigned long long below = (1ull << lane) - 1ull;
                const int n0 = __popcll(m0);
                if (k0) tl[1 + __popcll(m0 & below)] = lane;
                if (k1) tl[1 + n0 + __popcll(m1 & below)] = lane + 64;
                if (lane == 0) tl[0] = n0 + __popcll(m1);
            }
        }
    }
    __syncthreads();
    {
        const LAS int* tl = (const LAS int*)(sm + A_TL);
        const int nts = tl[0];
        FS st;
        int reps_ = REP_SEL; asm volatile("" : "+s"(reps_));
#pragma unroll 1
        for (int rep_ = 0; rep_ < reps_; ++rep_) {
        fs_init(st);
        int bg2 = bg; asm volatile("" : "+s"(bg2)); const bf16_t* pj = (const bf16_t*)(P->ws + WS_PROJ) + (size_t)((bg2 >> 1) * T) * PC + (bg2 & 1) * 64;
        flash_run<2, 0>(sm, pj + C_KS, pj + C_VS, PC, 0, nts, true, tl + 1, nullptr, 0.f, qf, st, mc, tid, lane, qloc);
        }
        const float il = st.l > 0.f ? NSA_GATE(1) / st.l : 0.f;
        st.o0 *= il; st.o1 *= il; opart_add(sm, tid, st.o0, st.o1); opart_store(sm, tid, st.o0, st.o1);
    }
    {
        const int f = qt >= 8 ? qt - 8 : 0;
        FS st; fs_init(st);
        int bg2 = bg; asm volatile("" : "+s"(bg2)); const bf16_t* pj = (const bf16_t*)(P->ws + WS_PROJ) + (size_t)((bg2 >> 1) * T) * PC + (bg2 & 1) * 64;
        flash_run<3, 0>(sm, pj + C_KW, pj + C_VW, PC, f, qt - f + 1, false, (const LAS int*)(sm + A_TL), nullptr, 0.f, qf, st, mc, tid, lane, qloc);
        const float il = st.l > 0.f ? NSA_GATE(2) / st.l : 0.f;
        st.o0 *= il; st.o1 *= il; opart_add(sm, tid, st.o0, st.o1);
        store_o((bf16_t*)(P->ws + WS_OA) + (size_t)(b * T + q) * 1024 + 512 + hq * 64, st.o0, st.o1, hi);
    }
    __syncthreads();
}

__device__ __forceinline__ void phase_attention(KParams P, lds_u8* sm, int G, int bid, int tid, int wid, int lane) {
    for (int w = bid; w < 256; w += G) {
        const int bh = w >> 4, qb = w & 15;
#pragma unroll 1
        for (int k = 0; k < 2 * REP_FOX; ++k) fox_unit(P, sm, bh, (k & 1) ? qb : 31 - qb, tid, wid, lane);
        const int bg = w >> 6, qt = w & 63;
#pragma unroll 1
        for (int k = 0; k < 2 * REP_NSA; ++k) nsa_unit(P, sm, bg, (k & 1) ? qt : 127 - qt, tid, wid, lane);
    }
}

#define XB_TMO      128
#define XB_XCNT(j)  (256  + 64 * (j))
#define XB_XSUB(j)  (1280 + 64 * (j))
#define XB_XGEN(j)  (2304 + 64 * (j))
#define XB_TOP      3328
#define XB_TOPGEN   3392
#define XCD_BAR_WORDS 3456
#define XB_SPIN_CAP (1u << 18)

__device__ __forceinline__ unsigned xb_ld(unsigned* p)              { return __hip_atomic_load(p, __ATOMIC_RELAXED, __HIP_MEMORY_SCOPE_AGENT); }
__device__ __forceinline__ unsigned xb_add(unsigned* p, unsigned v) { return __hip_atomic_fetch_add(p, v, __ATOMIC_RELAXED, __HIP_MEMORY_SCOPE_AGENT); }
__device__ __forceinline__ unsigned xb_xcc_id() { return (unsigned)__builtin_amdgcn_s_getreg((3 << 11) | 20) & 0xFu; }
#define XB_SPIN(cond, bar) do { unsigned _sp = 0; while (cond) { __builtin_amdgcn_s_sleep(1); \
    if ((++_sp & 255u) == 0u) { if (xb_ld(&(bar)[XB_TMO])) break; if (_sp > XB_SPIN_CAP) { atomicAdd(&(bar)[XB_TMO], 1u); break; } } } } while (0)

struct XcdBarrier {
    unsigned* bar; unsigned x;
    volatile LAS unsigned* st;
};

__device__ __forceinline__ XcdBarrier xcd_barrier_post(unsigned* bar, volatile LAS unsigned* st) {
    XcdBarrier b; b.bar = bar; b.x = xb_xcc_id(); b.st = st;
    if (threadIdx.x == 0) (void)xb_add(&bar[XB_XCNT(b.x)], 1u);
    return b;
}
__device__ __forceinline__ void xcd_barrier_complete(unsigned* bar, unsigned x, unsigned& nloc, unsigned& nx) {
    const unsigned G = gridDim.x * gridDim.y * gridDim.z;
    unsigned sum, cnt, mine, sp = 0u;
    for (;;) {
        sum = 0u; cnt = 0u; mine = 0u;
#pragma unroll
        for (unsigned j = 0; j < 16; ++j) { const unsigned c = xb_ld(&bar[XB_XCNT(j)]); sum += c; cnt += (c > 0u) ? 1u : 0u; mine = (j == x) ? c : mine; }
        if (sum == G) break;
        __builtin_amdgcn_s_sleep(1);
        if ((++sp & 255u) == 0u) { if (xb_ld(&bar[XB_TMO])) break; if (sp > XB_SPIN_CAP) { atomicAdd(&bar[XB_TMO], 1u); break; } }
    }
    nloc = mine > 0u ? mine : 1u; nx = cnt > 0u ? cnt : 1u;
}

__device__ __forceinline__ void xcd_barrier(const XcdBarrier& b) {
    asm volatile("s_waitcnt vmcnt(0)" ::: "memory");
    __syncthreads();
    if (threadIdx.x == 0) {
        unsigned* bar = b.bar; asm volatile("" : "+s"(bar)); unsigned bx_ = b.x; asm volatile("" : "+s"(bx_));
        __builtin_amdgcn_s_waitcnt(0);
        unsigned nloc = b.st[0], nx = b.st[1];
        if (nloc == 0u) { xcd_barrier_complete(bar, bx_, nloc, nx); b.st[0] = nloc; b.st[1] = nx; }
        const unsigned old = xb_add(&bar[XB_XSUB(bx_)], 1u);
        const unsigned gen = old / nloc;
        if (old + 1u == (gen + 1u) * nloc) {
            __builtin_amdgcn_fence(__ATOMIC_RELEASE, "agent");
            asm volatile("s_waitcnt vmcnt(0)" ::: "memory");
            const unsigned og = xb_add(&bar[XB_TOP], 1u);
            const unsigned tg = og / nx;
            if (og + 1u == (tg + 1u) * nx) xb_add(&bar[XB_TOPGEN], 1u);
            else XB_SPIN(xb_ld(&bar[XB_TOPGEN]) == tg, bar);
            __builtin_amdgcn_fence(__ATOMIC_ACQUIRE, "agent");
            xb_add(&bar[XB_XGEN(bx_)], 1u);
            asm volatile("s_waitcnt vmcnt(0)" ::: "memory");
        } else {
            XB_SPIN(xb_ld(&bar[XB_XGEN(bx_)]) == gen, bar);
            __builtin_amdgcn_fence(__ATOMIC_ACQUIRE, "agent");
            asm volatile("s_waitcnt vmcnt(0)" ::: "memory");
        }
    }
    __syncthreads();
}

__global__ void __launch_bounds__(512, 2) hybrid_fwd(Params Parg) {
    extern __shared__ __attribute__((aligned(16))) unsigned char smem_raw[];
    cg::grid_group grid = cg::this_grid();
#define FRESH() KParams P = (KParams)__builtin_amdgcn_kernarg_segment_ptr(); asm volatile("" : "+s"(P)); int G = gridDim.x, bid = blockIdx.x; asm volatile("" : "+s"(G), "+s"(bid)); \
                int tid = threadIdx.x; asm volatile("" : "+v"(tid)); lds_u8* sm = (lds_u8*)smem_raw; asm volatile("" : "+s"(sm)); (void)sm; const int wid = __builtin_amdgcn_readfirstlane(tid >> 6), lane = tid & 63; unsigned char* ws = P->ws; (void)wid; (void)lane; (void)ws; (void)G; (void)bid
#define LDSP ((PG8_LAS unsigned char*)smem_raw)
    XcdBarrier xbar;
    {
        FRESH();
        volatile LAS unsigned* bst = (volatile LAS unsigned*)(sm + 131072);
        if (tid == 0) { bst[0] = 0u; bst[1] = 0u; }
        __syncthreads();
        xbar = xcd_barrier_post((unsigned*)(ws + WS_BAR), bst);
        phase_x_to_bf16(P, G, bid, wid, lane);
    }
    for (int layer = 0; layer < 2; ++layer) {
#ifndef NO_W
        { int rw_ = REP_W; asm volatile("" : "+s"(rw_));
#pragma unroll 1
          for (int r_ = 0; r_ < rw_; ++r_) { FRESH(); phase_weights(P, layer, sm, G, bid, tid); } }
#endif
        xcd_barrier(xbar);
        if (gridDim.y == 0x7fffu) grid.sync();
        {
            FRESH();
            pg8::Gemm gm; gm.A = (const bf16_t*)(ws + WS_XB); gm.Bt = (const bf16_t*)(ws + WS_WIN); gm.M = M; gm.N = NPAD; gm.K = DM;
            pg8::StaticOrder so; so.init(M, NPAD, G, bid);
            EpiScaleBf16<0> ep; ep.O = (bf16_t*)(ws + WS_PROJ); ep.ldc = PC; ep.ncols = PC; ep.part = (const float*)(ws + WS_PART);
            pg8::gemm_phase<EpiScaleBf16<0>, pg8::StaticOrder, true, true>(LDSP, gm, so, ep);
        }
        xcd_barrier(xbar);
#ifndef NO_PREP
        { FRESH(); phase_prep(P, layer, sm, G, bid, tid, wid, lane); }
#endif
        xcd_barrier(xbar);
#ifndef NO_ATT
        { FRESH(); phase_attention(P, sm, G, bid, tid, wid, lane); }
#endif
        xcd_barrier(xbar);
        {
            FRESH();
            pg8::StaticOrder so; so.init(M, DM, G, bid);
            pg8::Gemm g1; g1.A = (const bf16_t*)(ws + WS_OA); g1.Bt = (const bf16_t*)(ws + WS_WOF); g1.M = M; g1.N = DM; g1.K = DM;
            EpiGateFused e1; e1.mix = (bf16_t*)(ws + WS_MIX); e1.proj = (const bf16_t*)(ws + WS_PROJ);
            pg8::gemm_phase<EpiGateFused, pg8::StaticOrder, true, true>(LDSP, g1, so, e1);
        }
        xcd_barrier(xbar);
        {
            FRESH();
            pg8::Gemm gm; gm.A = (const bf16_t*)(ws + WS_MIX); gm.Bt = (const bf16_t*)(ws + WS_WOUT); gm.M = M; gm.N = DM; gm.K = DM;
            pg8::StaticOrder so; so.init(M, DM, G, bid);
            EpiResidual ep; ep.xi = layer == 0 ? P->in[0] : (const float*)P->out; ep.xo = P->out; ep.xb = (bf16_t*)(ws + WS_XB); ep.part = (float*)(ws + WS_PART); ep.wxb = true;
            pg8::gemm_phase<EpiResidual, pg8::StaticOrder, true, true>(LDSP, gm, so, ep);
        }
        xcd_barrier(xbar);
        {
            FRESH();
            pg8::Gemm gm; gm.A = (const bf16_t*)(ws + WS_XB); gm.Bt = (const bf16_t*)(ws + WS_WUP); gm.M = M; gm.N = DFF; gm.K = DM;
            pg8::StaticOrder so; so.init(M, DFF, G, bid);
            EpiScaleBf16<1> ep; ep.O = (bf16_t*)(ws + WS_PROJ); ep.ldc = DFF; ep.ncols = DFF; ep.part = (const float*)(ws + WS_PART);
            pg8::gemm_phase<EpiScaleBf16<1>, pg8::StaticOrder, true, true>(LDSP, gm, so, ep);
        }
        xcd_barrier(xbar);
        {
            FRESH();
            pg8::Gemm gm; gm.A = (const bf16_t*)(ws + WS_PROJ); gm.Bt = (const bf16_t*)(ws + WS_WDN); gm.M = M; gm.N = DM; gm.K = DFF;
            pg8::StaticOrder so; so.init(M, DM, G, bid);
            EpiResidual ep; ep.xi = P->out; ep.xo = P->out; ep.xb = (bf16_t*)(ws + WS_XB); ep.part = (float*)(ws + WS_PART); ep.wxb = (layer == 0);
            pg8::gemm_phase<EpiResidual, pg8::StaticOrder, true, true>(LDSP, gm, so, ep);
        }
        xcd_barrier(xbar);
    }
    {
        FRESH();
        const float* gf = P->in[15]; float* XA = P->out; const float* PART = (const float*)(ws + WS_PART);
        f32x4 gv[4];
#pragma unroll
        for (int i = 0; i < 4; ++i) gv[i] = ((const f32x4*)gf)[lane + 64 * i];
        for (int row0 = bid * 8 + wid; row0 < M; row0 += 4 * G * 8) {
            f32x4 v[4][4]; float rs[4];
#pragma unroll
            for (int k = 0; k < 4; ++k) {
                const int row = row0 + k * G * 8, rr = row < M ? row : row0;
                rs[k] = row_rstd(PART, rr);
#pragma unroll
                for (int i = 0; i < 4; ++i) v[k][i] = ((const f32x4*)(XA + (size_t)rr * DM))[lane + 64 * i];
            }
            asm volatile("" ::: "memory");
#pragma unroll
            for (int k = 0; k < 4; ++k) {
                const int row = row0 + k * G * 8;
                if (row < M) {
#pragma unroll
                    for (int i = 0; i < 4; ++i) ((f32x4*)(XA + (size_t)row * DM))[lane + 64 * i] = v[k][i] * rs[k] * gv[i];
                }
            }
        }
    }
}

extern "C" void kernel_launch(void* const* d_in, const int* in_sizes, int n_in, void* d_out, int out_size, void* d_ws, size_t ws_size, hipStream_t stream) {
    static int grid_blocks = 0;
    if (!grid_blocks) {
        int dev = 0, cus = 0, per_cu = 0;
        hipGetDevice(&dev);
        hipDeviceGetAttribute(&cus, hipDeviceAttributeMultiprocessorCount, dev);
        if (hipFuncSetAttribute((const void*)hybrid_fwd, hipFuncAttributeMaxDynamicSharedMemorySize, LDS_BYTES) != hipSuccess) fprintf(stderr, "hipFuncSetAttribute failed\n");
        hipOccupancyMaxActiveBlocksPerMultiprocessor(&per_cu, hybrid_fwd, 512, LDS_BYTES);
        if (per_cu < 1) per_cu = 1;
        grid_blocks = cus * per_cu;
        if (grid_blocks > 256) grid_blocks = 256;
    }
    if (hipMemsetAsync((char*)d_ws + WS_BAR, 0, 16384, stream) != hipSuccess) fprintf(stderr, "memset failed\n");
    Params p{};
    for (int i = 0; i < 16; ++i) p.in[i] = (const float*)d_in[i];
    p.out = (float*)d_out; p.ws = (unsigned char*)d_ws;
    void* args[] = {&p};
    hipError_t e = hipLaunchCooperativeKernel((void*)hybrid_fwd, dim3(grid_blocks), dim3(512), args, LDS_BYTES, stream);
    if (e != hipSuccess) fprintf(stderr, "cooperative launch failed: %s (grid %d)\n", hipGetErrorString(e), grid_blocks);
}
```

```cpp
#include <hip/hip_runtime.h>
#include <hip/hip_cooperative_groups.h>
#include <cstdio>
#include <cstdint>
#include <cmath>
namespace cg = cooperative_groups;
namespace pg8 {
#define PG8_LAS __attribute__((address_space(3)))
typedef unsigned short bf16_t;
typedef short bf16x8 __attribute__((ext_vector_type(8)));
typedef float f32x4 __attribute__((ext_vector_type(4)));
typedef unsigned u32x4 __attribute__((ext_vector_type(4)));
constexpr int BM = 256, BK = 64, HALF = 128, HTB = HALF * BK * 2  , STAGE_BYTES = 8 * HTB, NXCD = 8, WGM = 8;

__host__ __device__ __forceinline__ int lds_byte(int r, int c) { const int st = (r >> 4) * 2 + (c >> 5), rr = r & 15, cc = c & 31, ob = rr * 64 + cc * 2; return st * 1024 + (ob ^ (((ob >> 9) & 1) << 5)); }
__host__ __device__ __forceinline__ void stage_rc(int b, int& R, int& C) { const int st = b / 1024, sb = b % 1024, swz = sb ^ (((sb >> 9) & 1) << 5); R = (st >> 1) * 16 + swz / 64; C = (st & 1) * 32 + (swz % 64) / 2; }
__host__ __device__ __forceinline__ int perm32(int rho) { const int n = rho >> 4, i = rho & 15; return 8 * (i >> 2) + 4 * n + (i & 3); }

struct Unit { int pm, pn; };
struct Gemm { const bf16_t* A; const bf16_t* Bt; int M, N, K; };

struct StaticOrder {
    int nM, nN, nwg, G, c;
    __host__ __device__ void init(int M, int N, int G_, int c_) { nM = M / BM; nN = N / BM; nwg = nM * nN; G = G_; c = c_; }
    __host__ __device__ bool next(int i, Unit& u) const {
        const long L = (long)i * G + c; if (L >= nwg) return false;
        int wgid = (int)L; { const int q = nwg / NXCD, r = nwg % NXCD, xcd = wgid % NXCD, off = wgid / NXCD; wgid = (xcd < r ? xcd * (q + 1) : r * (q + 1) + (xcd - r) * q) + off; }
        const int nig = WGM * nN, gid = wgid / nig, fm = gid * WGM, gsz = (nM - fm) < WGM ? (nM - fm) : WGM;
        u.pm = fm + ((wgid % nig) % gsz); u.pn = (wgid % nig) / gsz; return true;
    }
    __device__ __forceinline__ void a_ready(const Unit&) const {}
    __device__ __forceinline__ void done(const Unit&) const {}
};

__device__ __forceinline__ unsigned cvt_pk_bf16(float lo, float hi) { unsigned r; asm volatile("v_cvt_pk_bf16_f32 %0, %1, %2" : "=v"(r) : "v"(lo), "v"(hi)); return r; }

template <class Epi, class Sched, bool ALIGN_EPI = false, bool SP2 = false>
__device__ __forceinline__ void gemm_phase(PG8_LAS unsigned char* lds, const Gemm g, const Sched& S, const Epi& E) {
    int tid_ = threadIdx.x; asm volatile("" : "+v"(tid_));
    const int tid = tid_, wid = __builtin_amdgcn_readfirstlane(tid >> 6), lane = tid & 63, wr = wid >> 2, wc = wid & 3, fr = lane & 15, fq = lane >> 4;
    const int K = g.K, nt = K / BK;
    unsigned voffA[2], voffB[2];
#pragma unroll
    for (int i = 0; i < 2; ++i) { int R, C; stage_rc(tid * 16 + i * 8192, R, C); const int Rb = Epi::PERM ? ((R & ~31) + perm32(R & 31)) : R;
        voffA[i] = (unsigned)(R * K + C) * 2u; voffB[i] = (unsigned)(Rb * K + C) * 2u; }
    const size_t kstep = (size_t)(BK * 2);
    const size_t hstep = (size_t)HALF * K * 2;
    const size_t tstep = 2 * hstep;
    const unsigned ldsw = (unsigned)wid * 1024u;
    const int aoff = lds_byte(wr * 64 + fr, fq * 8), boff = lds_byte(wc * 32 + fr, fq * 8);
#define PG8_SA(b, h) (((b) * 2 + (h)) * HTB)
#define PG8_SB(b, h) ((4 + (b) * 2 + (h)) * HTB)
#define PG8_STAGE(bufoff, gbase, voff) do { _Pragma("unroll") for (int _i = 0; _i < 2; ++_i) \
        __builtin_amdgcn_global_load_lds((const unsigned*)((const char*)(gbase) + (voff)[_i]), (PG8_LAS unsigned*)(lds + (bufoff) + ldsw + _i * 8192), 16, 0, 0); } while (0)
#define PG8_LDA(dst, b, h) do { _Pragma("unroll") for (int m = 0; m < 4; ++m) _Pragma("unroll") for (int k = 0; k < 2; ++k) dst[m][k] = *(const PG8_LAS bf16x8*)(lds + PG8_SA(b, h) + aoff + m * 2048 + k * 1024); } while (0)
#define PG8_LDB(dst, b, h) do { _Pragma("unroll") for (int n = 0; n < 2; ++n) _Pragma("unroll") for (int k = 0; k < 2; ++k) dst[n][k] = *(const PG8_LAS bf16x8*)(lds + PG8_SB(b, h) + boff + n * 2048 + k * 1024); } while (0)
#define PG8_MMA(ai, bj, At, Bt) do { __builtin_amdgcn_s_setprio(1); _Pragma("unroll") for (int m = 0; m < 4; ++m) _Pragma("unroll") for (int n = 0; n < 2; ++n) _Pragma("unroll") for (int k = 0; k < 2; ++k) \
        acc[ai][bj][m][n] = __builtin_amdgcn_mfma_f32_16x16x32_bf16(Bt[n][k], At[m][k], acc[ai][bj][m][n], 0, 0, 0); __builtin_amdgcn_s_setprio(0); } while (0)
#define PG8_WAIT_V(n) asm volatile("s_waitcnt vmcnt(" #n ")" ::: "memory")
#define PG8_WAIT_L(n) asm volatile("s_waitcnt lgkmcnt(" #n ")" ::: "memory")
#define PG8_BAR __builtin_amdgcn_s_barrier()
#define PG8_SCHED __builtin_amdgcn_sched_barrier(0)
    Unit cur, nxt; int ui = 0;
    if (!S.next(0, cur)) return;
    f32x4 acc[2][2][4][2];
#pragma unroll
    for (int a = 0; a < 2; ++a)
#pragma unroll
        for (int b = 0; b < 2; ++b)
#pragma unroll
            for (int m = 0; m < 4; ++m)
#pragma unroll
                for (int n = 0; n < 2; ++n) acc[a][b][m][n] = (f32x4){0.f, 0.f, 0.f, 0.f};
    bf16x8 At[4][2], B0[2][2], B1[2][2];
    const char* cA = (const char*)g.A + (size_t)cur.pm * tstep; const char* cB = (const char*)g.Bt + (size_t)cur.pn * tstep;
    S.a_ready(cur);
    if constexpr (SP2) {
        PG8_STAGE(PG8_SB(0, 0), cB, voffB); PG8_STAGE(PG8_SB(0, 1), cB + hstep, voffB); PG8_STAGE(PG8_SA(0, 0), cA, voffA); PG8_STAGE(PG8_SA(0, 1), cA + hstep, voffA);
        if (wr == 1) PG8_BAR;
        PG8_WAIT_V(2); PG8_BAR;
        PG8_STAGE(PG8_SB(1, 0), cB + kstep, voffB); PG8_STAGE(PG8_SA(1, 0), cA + kstep, voffA); PG8_STAGE(PG8_SB(1, 1), cB + hstep + kstep, voffB);
        PG8_WAIT_V(6); PG8_BAR;
    } else {
        PG8_STAGE(PG8_SB(0, 0), cB, voffB); PG8_STAGE(PG8_SA(0, 0), cA, voffA); PG8_STAGE(PG8_SB(0, 1), cB + hstep, voffB); PG8_STAGE(PG8_SA(0, 1), cA + hstep, voffA);
        if (wr == 1) PG8_BAR;
        PG8_WAIT_V(4); PG8_BAR;
        PG8_STAGE(PG8_SB(1, 0), cB + kstep, voffB); PG8_STAGE(PG8_SA(1, 0), cA + kstep, voffA); PG8_STAGE(PG8_SB(1, 1), cB + hstep + kstep, voffB);
        PG8_WAIT_V(6); PG8_BAR;
    }
    for (;;) {
        const bool has_next = S.next(ui + 1, nxt);
        const char* nA = has_next ? (const char*)g.A + (size_t)nxt.pm * tstep : cA; const char* nB = has_next ? (const char*)g.Bt + (size_t)nxt.pn * tstep : cB;
#pragma unroll 1
        for (int kr_ = 0; kr_ < ((Epi::MID_T >= 0) ? 2 : 1); ++kr_) {
        const int tb_ = (Epi::MID_T >= 0 && kr_ == 1) ? Epi::MID_T : 0, te_ = (Epi::MID_T >= 0 && kr_ == 0) ? Epi::MID_T : nt;
        if constexpr (Epi::MID_T >= 0) { if (kr_ == 1) E.mid(acc, cur, wr, wc, fr, fq); }
        for (int t = tb_; t < te_; t += 2) {
            const bool last = (t == nt - 2);
            const char* a1 = cA + (size_t)(t + 1) * kstep;
            const char* a2 = last ? nA : cA + (size_t)(t + 2) * kstep; const char* b2 = last ? nB : cB + (size_t)(t + 2) * kstep;
            const char* a3 = a2 + kstep; const char* b3 = b2 + kstep;
            if (last && has_next) S.a_ready(nxt);
            if constexpr (SP2) {
            PG8_LDB(B0, 0, 0); PG8_LDB(B1, 0, 1); PG8_SCHED; PG8_LDA(At, 0, 0); PG8_STAGE(PG8_SA(1, 1), a1 + hstep, voffA);
            PG8_WAIT_V(8); PG8_WAIT_L(0); PG8_BAR; PG8_MMA(0, 0, At, B0); PG8_MMA(0, 1, At, B1); PG8_BAR; PG8_SCHED;
            PG8_LDA(At, 0, 1); PG8_STAGE(PG8_SB(0, 0), b2, voffB); PG8_STAGE(PG8_SB(0, 1), b2 + hstep, voffB); PG8_STAGE(PG8_SA(0, 0), a2, voffA);
            PG8_WAIT_V(8); PG8_WAIT_L(0); PG8_BAR; PG8_MMA(1, 0, At, B0); PG8_MMA(1, 1, At, B1); PG8_BAR; PG8_SCHED;
            PG8_LDB(B0, 1, 0); PG8_LDB(B1, 1, 1); PG8_SCHED; PG8_LDA(At, 1, 0); PG8_STAGE(PG8_SA(0, 1), a2 + hstep, voffA);
            PG8_WAIT_V(8); PG8_WAIT_L(0); PG8_BAR; PG8_MMA(0, 0, At, B0); PG8_MMA(0, 1, At, B1); PG8_BAR; PG8_SCHED;
            PG8_LDA(At, 1, 1); PG8_STAGE(PG8_SB(1, 0), b3, voffB); PG8_STAGE(PG8_SB(1, 1), b3 + hstep, voffB); PG8_STAGE(PG8_SA(1, 0), a3, voffA);
            PG8_WAIT_V(8); PG8_WAIT_L(0); PG8_BAR; PG8_MMA(1, 0, At, B0); PG8_MMA(1, 1, At, B1); PG8_BAR; PG8_SCHED;
            } else {
            PG8_LDB(B0, 0, 0); PG8_SCHED; PG8_LDA(At, 0, 0); PG8_STAGE(PG8_SA(1, 1), a1 + hstep, voffA);
            PG8_WAIT_L(8); PG8_BAR; PG8_WAIT_L(0); PG8_MMA(0, 0, At, B0); PG8_BAR; PG8_SCHED;
            PG8_LDB(B1, 0, 1); PG8_STAGE(PG8_SB(0, 0), b2, voffB);
            PG8_BAR; PG8_WAIT_L(0); PG8_MMA(0, 1, At, B1); PG8_BAR;
            PG8_LDA(At, 0, 1); PG8_STAGE(PG8_SA(0, 0), a2, voffA);
            PG8_BAR; PG8_WAIT_L(0); PG8_MMA(1, 0, At, B0); PG8_BAR; PG8_SCHED;
            PG8_STAGE(PG8_SB(0, 1), b2 + hstep, voffB);
            PG8_WAIT_V(6); PG8_BAR; PG8_MMA(1, 1, At, B1); PG8_BAR;
            PG8_LDB(B0, 1, 0); PG8_SCHED; PG8_LDA(At, 1, 0); PG8_STAGE(PG8_SA(0, 1), a2 + hstep, voffA);
            PG8_WAIT_L(8); PG8_BAR; PG8_WAIT_L(0); PG8_MMA(0, 0, At, B0); PG8_BAR; PG8_SCHED;
            PG8_LDB(B1, 1, 1); PG8_STAGE(PG8_SB(1, 0), b3, voffB);
            PG8_BAR; PG8_WAIT_L(0); PG8_MMA(0, 1, At, B1); PG8_BAR;
            PG8_LDA(At, 1, 1); PG8_STAGE(PG8_SA(1, 0), a3, voffA);
            PG8_BAR; PG8_WAIT_L(0); PG8_MMA(1, 0, At, B0); PG8_BAR; PG8_SCHED;
            PG8_STAGE(PG8_SB(1, 1), b3 + hstep, voffB);
            PG8_WAIT_V(6); PG8_BAR; PG8_MMA(1, 1, At, B1); PG8_BAR;
            }
        }
        }
        if constexpr (ALIGN_EPI) { if (wr == 0) PG8_BAR; }
        if constexpr (!Epi::AFTER_DRAIN) { E(acc, cur, wr, wc, fr, fq); S.done(cur); }
        if (!has_next) break;
#pragma unroll
        for (int a = 0; a < 2; ++a)
#pragma unroll
            for (int b = 0; b < 2; ++b)
#pragma unroll
                for (int m = 0; m < 4; ++m)
#pragma unroll
                    for (int n = 0; n < 2; ++n) acc[a][b][m][n] = (f32x4){0.f, 0.f, 0.f, 0.f};
        cur = nxt; cA = nA; cB = nB; ++ui;
        if constexpr (ALIGN_EPI) { if (wr == 1) PG8_BAR; }
    }
    PG8_WAIT_V(0);
    if constexpr (!ALIGN_EPI) { if (wr == 0) PG8_BAR; }
    PG8_BAR;
    if constexpr (Epi::AFTER_DRAIN) { E.fused(acc, cur, wr, wc, fr, fq, lds, wid, lane); S.done(cur); }
#undef PG8_SA
#undef PG8_SB
#undef PG8_STAGE
#undef PG8_LDA
#undef PG8_LDB
#undef PG8_MMA
#undef PG8_WAIT_V
#undef PG8_WAIT_L
#undef PG8_BAR
#undef PG8_SCHED
}
}

using pg8::bf16_t; using pg8::bf16x8; using pg8::f32x4; using pg8::u32x4;
typedef short s16x4 __attribute__((ext_vector_type(4)));
typedef float f32x16 __attribute__((ext_vector_type(16)));
typedef unsigned u32x2 __attribute__((ext_vector_type(2)));
typedef float f32x2 __attribute__((ext_vector_type(2)));
#define LAS __attribute__((address_space(3)))
typedef LAS unsigned char lds_u8;

constexpr int NB = 2, T = 8192, DM = 1024, M = NB * T, PC = 4896, NPAD = 5120, DFF = 4096;
constexpr int C_QA = 0, C_KA = 512, C_VA = 1024, C_QB = 1536, C_KC = 2048, C_VC = 2176, C_KS = 2304, C_VS = 2432, C_KW = 2560, C_VW = 2688,
              C_GA = 2816, C_GB = 3840, C_F = 4864, C_G3 = 4872;
constexpr float LOG2E = 1.4426950408889634f, QSCALE = 0.125f * LOG2E, RMS_EPS = 1e-6f;
constexpr size_t MiB = 1u << 20;
constexpr size_t WS_KNT = 2 * MiB + 64 * 1024;
constexpr size_t WS_TOT = WS_KNT + 8192;
constexpr size_t WS_BAR = 2 * MiB + 512 * 1024;
constexpr size_t WS_PART = 0, WS_CUM = 1 * MiB, WS_KC = WS_CUM + 512 * 1024, WS_PB1 = 2 * MiB;
constexpr size_t WS_WIN = 3 * MiB, WS_WOF = 13 * MiB, WS_WON = 14 * MiB, WS_WOUT = 15 * MiB, WS_WUP = 17 * MiB, WS_WDN = 25 * MiB, WS_WC1 = 33 * MiB, WS_WC2 = 35 * MiB;
constexpr size_t WS_PROJ = 36 * MiB, WS_XB = 190 * MiB, WS_OA = 190 * MiB, WS_ON = 206 * MiB, WS_MIX = 222 * MiB;
constexpr int LDS_BYTES = 135168;
constexpr int REP_FOX = 1, REP_NSA = 1, REP_G1 = 1, REP_G5 = 1, REP_W = 1, REP_SEL = 1, REP_TOPK = 1, REP_CMP = 1, REP_G23 = 1;

struct Params { const float* in[16]; float* out; unsigned char* ws; };
typedef const __attribute__((address_space(4))) Params* KParams;

__device__ __forceinline__ unsigned pk2(float lo, float hi) {
    typedef float f2 __attribute__((ext_vector_type(2))); typedef __bf16 b2 __attribute__((ext_vector_type(2)));
    f2 v = {lo, hi}; b2 b = __builtin_convertvector(v, b2); return __builtin_bit_cast(unsigned, b);
}
__device__ __forceinline__ float bf2f(unsigned short h) { return __uint_as_float(((unsigned)h) << 16); }
__device__ __forceinline__ float bflo(unsigned w) { return __uint_as_float(w << 16); }
__device__ __forceinline__ float bfhi(unsigned w) { return __uint_as_float(w & 0xffff0000u); }
__device__ __forceinline__ float wave_sum(float v) {
#pragma unroll
    for (int o = 32; o >= 1; o >>= 1) v += __shfl_xor(v, o);
    return v;
}
__device__ __forceinline__ float sigmoidf_(float z) { return 1.0f / (1.0f + __expf(-z)); }
__device__ __forceinline__ float row_rstd(const float* part, int row) {
    const f32x4* p = (const f32x4*)(part + (size_t)row * 16);
    f32x4 a = p[0], b = p[1], c = p[2], d = p[3];
    float s = ((a[0] + a[1]) + (a[2] + a[3])) + ((b[0] + b[1]) + (b[2] + b[3])) + ((c[0] + c[1]) + (c[2] + c[3])) + ((d[0] + d[1]) + (d[2] + d[3]));
    return rsqrtf(s * (1.0f / 1024.0f) + RMS_EPS);
}
__device__ __forceinline__ int src_col(int n) {
    if (n < 1536) return n;
    if (n < 2816) return n + 8;
    if (n < 4864) return n + 32;
    if (n < 4872) return n - 4864 + 1536;
    return n - 4872 + 2824;
}
__device__ __forceinline__ void rope_cs(int pos, int i, float& cs, float& sn) {
    const float inv = exp2f(-(float)i * (18.931568569324174f / 8.0f));
    const float ang = (float)pos * inv;
    const float k = rintf(ang * 0.15915494309189535f);
    float r = fmaf(-k, 6.2831854820251465f, ang); r = fmaf(-k, -1.7484555e-7f, r);
    cs = __cosf(r); sn = __sinf(r);
}

__device__ __forceinline__ int vt_pos(int kv) { const int q = (kv >> 2) & 3; return (kv & ~12) | ((((q == 1) ? 2 : (q == 2) ? 1 : q)) << 2); }
template <int ACT  > struct EpiScaleBf16 {
    static constexpr bool PERM = true, AFTER_DRAIN = false; static constexpr int MID_T = -1;
    bf16_t* O; int ldc; int ncols; const float* part;
    __device__ __forceinline__ void operator()(const f32x4 (&acc)[2][2][4][2], const pg8::Unit& u, int wr, int wc, int fr, int fq) const {
#pragma unroll
        for (int ai = 0; ai < 2; ++ai)
#pragma unroll
            for (int m = 0; m < 4; ++m) {
                const int row = u.pm * 256 + ai * 128 + wr * 64 + m * 16 + fr;
                const float rs = row_rstd(part, row);
#pragma unroll
                for (int bj = 0; bj < 2; ++bj) {
                    const int colb = u.pn * 256 + bj * 128, col = colb + wc * 32 + 8 * fq;
                    if (col < ncols) {
                        f32x4 v0 = acc[ai][bj][m][0] * rs, v1 = acc[ai][bj][m][1] * rs;
                        if (ACT == 1) {
#pragma unroll
                            for (int e = 0; e < 4; ++e) { float a = fmaxf(v0[e], 0.f), b = fmaxf(v1[e], 0.f); v0[e] = a * a; v1[e] = b * b; }
                        }
                        u32x4 w; w.x = pk2(v0[0], v0[1]); w.y = pk2(v0[2], v0[3]); w.z = pk2(v1[0], v1[1]); w.w = pk2(v1[2], v1[3]);
                        const bool vt = (ACT == 0) && ((colb >= C_VA && colb < C_VA + 512) || colb == C_VS || colb == C_VW);
                        if (vt) {
                            unsigned short* tp = O + (size_t)((row & ~63) + (col & 63)) * ldc + (col & ~63) + vt_pos(row & 63);
                            tp[0] = (unsigned short)(w.x & 0xffffu); tp[(size_t)1 * ldc] = (unsigned short)(w.x >> 16); tp[(size_t)2 * ldc] = (unsigned short)(w.y & 0xffffu); tp[(size_t)3 * ldc] = (unsigned short)(w.y >> 16);
                            tp[(size_t)4 * ldc] = (unsigned short)(w.z & 0xffffu); tp[(size_t)5 * ldc] = (unsigned short)(w.z >> 16); tp[(size_t)6 * ldc] = (unsigned short)(w.w & 0xffffu); tp[(size_t)7 * ldc] = (unsigned short)(w.w >> 16);
                        } else *(u32x4*)(O + (size_t)row * ldc + col) = w;
                    }
                }
                if (m & 1) asm volatile("" ::: "memory");
            }
    }
};
template <bool FIRST> struct EpiGateMix {
    static constexpr bool PERM = false, AFTER_DRAIN = false; static constexpr int MID_T = -1;
    bf16_t* mix; const bf16_t* proj; int gcol0;
    __device__ __forceinline__ void operator()(const f32x4 (&acc)[2][2][4][2], const pg8::Unit& u, int wr, int wc, int fr, int fq) const {
#pragma unroll
        for (int ai = 0; ai < 2; ++ai)
#pragma unroll
            for (int m = 0; m < 4; ++m) {
                const int row = u.pm * 256 + ai * 128 + wr * 64 + m * 16 + fr;
#pragma unroll
                for (int bj = 0; bj < 2; ++bj)
#pragma unroll
                    for (int n = 0; n < 2; ++n) {
                        const int col = u.pn * 256 + bj * 128 + wc * 32 + 16 * n + 4 * fq;
                        const u32x2 g = *(const u32x2*)(proj + (size_t)row * PC + gcol0 + col);
                        const f32x4 a = acc[ai][bj][m][n];
                        float r0 = sigmoidf_(bflo(g.x)) * a[0], r1 = sigmoidf_(bfhi(g.x)) * a[1], r2 = sigmoidf_(bflo(g.y)) * a[2], r3 = sigmoidf_(bfhi(g.y)) * a[3];
                        bf16_t* mp = mix + (size_t)row * DM + col;
                        if (!FIRST) { const u32x2 o = *(const u32x2*)mp; r0 += bflo(o.x); r1 += bfhi(o.x); r2 += bflo(o.y); r3 += bfhi(o.y); }
                        u32x2 w; w.x = pk2(r0, r1); w.y = pk2(r2, r3); *(u32x2*)mp = w;
                    }
                asm volatile("" ::: "memory");
            }
    }
};
struct EpiGateFused {
    static constexpr bool PERM = false, AFTER_DRAIN = false; static constexpr int MID_T = 8;
    bf16_t* mix; const bf16_t* proj;
    __device__ __forceinline__ static float eneg(float g) { return fminf(__expf(-g), 1e30f); }
    __device__ __forceinline__ void mid(f32x4 (&acc)[2][2][4][2], const pg8::Unit& u, int wr, int wc, int fr, int fq) const {
#pragma unroll
        for (int ai = 0; ai < 2; ++ai)
#pragma unroll
            for (int m = 0; m < 4; ++m) {
                int row = u.pm * 256 + ai * 128 + wr * 64 + m * 16 + fr; asm volatile("" : "+v"(row));
#pragma unroll
                for (int bj = 0; bj < 2; ++bj)
#pragma unroll
                    for (int n = 0; n < 2; ++n) {
                        const int col = u.pn * 256 + bj * 128 + wc * 32 + 16 * n + 4 * fq;
                        const unsigned go = (unsigned)row * (unsigned)PC + (unsigned)col;
                        const u32x2 ga = *(const u32x2*)(proj + C_GA + go), gb = *(const u32x2*)(proj + C_GB + go);
                        f32x4 a = acc[ai][bj][m][n];
                        a[0] *= (1.0f + eneg(bflo(gb.x))) * __builtin_amdgcn_rcpf(1.0f + eneg(bflo(ga.x))); a[1] *= (1.0f + eneg(bfhi(gb.x))) * __builtin_amdgcn_rcpf(1.0f + eneg(bfhi(ga.x)));
                        a[2] *= (1.0f + eneg(bflo(gb.y))) * __builtin_amdgcn_rcpf(1.0f + eneg(bflo(ga.y))); a[3] *= (1.0f + eneg(bfhi(gb.y))) * __builtin_amdgcn_rcpf(1.0f + eneg(bfhi(ga.y)));
                        acc[ai][bj][m][n] = a;
                        asm volatile("" : "+v"(acc[ai][bj][m][n]) :: "memory");
                    }
            }
    }
    __device__ __forceinline__ void operator()(const f32x4 (&acc)[2][2][4][2], const pg8::Unit& u, int wr, int wc, int fr, int fq) const {
#pragma unroll
        for (int ai = 0; ai < 2; ++ai)
#pragma unroll
            for (int m = 0; m < 4; ++m) {
                int row = u.pm * 256 + ai * 128 + wr * 64 + m * 16 + fr; asm volatile("" : "+v"(row));
#pragma unroll
                for (int bj = 0; bj < 2; ++bj)
#pragma unroll
                    for (int n = 0; n < 2; ++n) {
                        const int col = u.pn * 256 + bj * 128 + wc * 32 + 16 * n + 4 * fq;
                        const u32x2 gb = *(const u32x2*)(proj + C_GB + (unsigned)row * (unsigned)PC + (unsigned)col);
                        const f32x4 a = acc[ai][bj][m][n];
                        const float r0 = a[0] * __builtin_amdgcn_rcpf(1.0f + eneg(bflo(gb.x))), r1 = a[1] * __builtin_amdgcn_rcpf(1.0f + eneg(bfhi(gb.x)));
                        const float r2 = a[2] * __builtin_amdgcn_rcpf(1.0f + eneg(bflo(gb.y))), r3 = a[3] * __builtin_amdgcn_rcpf(1.0f + eneg(bfhi(gb.y)));
                        u32x2 w; w.x = pk2(r0, r1); w.y = pk2(r2, r3); *(u32x2*)(mix + ((unsigned)row * (unsigned)DM + (unsigned)col)) = w;
                    }
                if (m & 1) asm volatile("" ::: "memory");
            }
    }
};
struct EpiResidual {
    static constexpr bool PERM = false, AFTER_DRAIN = false; static constexpr int MID_T = -1;
    const float* xi; float* xo; bf16_t* xb; float* part; bool wxb;
    __device__ __forceinline__ void operator()(const f32x4 (&acc)[2][2][4][2], const pg8::Unit& u, int wr, int wc, int fr, int fq) const {
#pragma unroll
        for (int ai = 0; ai < 2; ++ai)
#pragma unroll
            for (int m = 0; m < 4; ++m) {
                const int row = u.pm * 256 + ai * 128 + wr * 64 + m * 16 + fr;
                float ss = 0.f;
#pragma unroll
                for (int bj = 0; bj < 2; ++bj)
#pragma unroll
                    for (int n = 0; n < 2; ++n) {
                        const int col = u.pn * 256 + bj * 128 + wc * 32 + 16 * n + 4 * fq;
                        const size_t off = (size_t)row * DM + col;
                        f32x4 v = *(const f32x4*)(xi + off) + acc[ai][bj][m][n];
                        *(f32x4*)(xo + off) = v;
                        if (wxb) { u32x2 w; w.x = pk2(v[0], v[1]); w.y = pk2(v[2], v[3]); *(u32x2*)(xb + off) = w; }
                        ss += (v[0] * v[0] + v[1] * v[1]) + (v[2] * v[2] + v[3] * v[3]);
                    }
                ss += __shfl_xor(ss, 16); ss += __shfl_xor(ss, 32);
                if (fq == 0) part[(size_t)row * 16 + u.pn * 4 + wc] = ss;
                asm volatile("" ::: "memory");
            }
    }
};

struct WTile { const float* W; bf16_t* WT; const float* rs; int K, Nsrc, Ndst, ldk, koff, mode, kt, nt; };
constexpr int W_NTILES = 1032;
__device__ __forceinline__ WTile wtile_decode(KParams P, int layer, int g) {
    unsigned char* ws = P->ws;
    WTile t; int base;
    if (g < 320)       { base = 0;    t.W = P->in[2] + (size_t)layer * DM * PC;   t.WT = (bf16_t*)(ws + WS_WIN);  t.rs = P->in[1] + layer * DM;  t.K = DM;   t.Nsrc = PC;  t.Ndst = PC;  t.ldk = DM;   t.koff = 0;   t.mode = 1; }
    else if (g < 576)  { base = 320;  t.W = P->in[13] + (size_t)layer * DM * DFF; t.WT = (bf16_t*)(ws + WS_WUP);  t.rs = P->in[12] + layer * DM; t.K = DM;   t.Nsrc = DFF; t.Ndst = DFF; t.ldk = DM;   t.koff = 0;   t.mode = 0; }
    else if (g < 832)  { base = 576;  t.W = P->in[14] + (size_t)layer * DFF * DM; t.WT = (bf16_t*)(ws + WS_WDN);  t.rs = nullptr;                t.K = DFF;  t.Nsrc = DM;  t.Ndst = DM;  t.ldk = DFF;  t.koff = 0;   t.mode = 0; }
    else if (g < 896)  { base = 832;  t.W = P->in[11] + (size_t)layer * DM * DM;  t.WT = (bf16_t*)(ws + WS_WOUT); t.rs = nullptr;                t.K = DM;   t.Nsrc = DM;  t.Ndst = DM;  t.ldk = DM;   t.koff = 0;   t.mode = 0; }
    else if (g < 928)  { base = 896;  t.W = P->in[9] + (size_t)layer * 512 * DM;  t.WT = (bf16_t*)(ws + WS_WOF);  t.rs = nullptr;                t.K = 512;  t.Nsrc = DM;  t.Ndst = DM;  t.ldk = 1024; t.koff = 0;   t.mode = 0; }
    else if (g < 960)  { base = 928;  t.W = P->in[10] + (size_t)layer * 512 * DM; t.WT = (bf16_t*)(ws + WS_WOF);  t.rs = nullptr;                t.K = 512;  t.Nsrc = DM;  t.Ndst = DM;  t.ldk = 1024; t.koff = 512; t.mode = 0; }
    else if (g < 1024) { const int kv = (g - 960) >> 5; base = 960 + 32 * kv;  t.W = P->in[5] + (size_t)(layer * 2 + kv) * 2048 * 256; t.WT = (bf16_t*)(ws + WS_WC1) + (size_t)kv * 256 * 2048; t.rs = nullptr; t.K = 2048; t.Nsrc = 256; t.Ndst = 256; t.ldk = 2048; t.koff = 0; t.mode = 0; }
    else               { const int kv = (g - 1024) >> 2; base = 1024 + 4 * kv; t.W = P->in[7] + (size_t)(layer * 2 + kv) * 256 * 64;   t.WT = (bf16_t*)(ws + WS_WC2) + (size_t)kv * 64 * 256;   t.rs = nullptr; t.K = 256;  t.Nsrc = 64;  t.Ndst = 64;  t.ldk = 256;  t.koff = 0; t.mode = 0; }
    const int tl = g - base, nkt = t.K >> 6;
    t.kt = tl % nkt; t.nt = tl / nkt;
    return t;
}
__device__ __forceinline__ void wtile_issue(const WTile& t, int tid, f32x4 (&v)[8], float (&rs)[8]) {
    const int c4 = tid & 63, r0 = tid >> 6, nd = t.nt * 256 + 4 * c4;
    const bool ok = nd < t.Ndst;
    const int ns = t.mode ? src_col(nd) : nd;
#pragma unroll
    for (int i = 0; i < 8; ++i) {
        const int k = t.kt * 64 + r0 + 8 * i;
        v[i] = ok ? *(const f32x4*)(t.W + (size_t)k * t.Nsrc + ns) : (f32x4){0.f, 0.f, 0.f, 0.f};
        rs[i] = t.rs ? t.rs[k] : 1.0f;
    }
}
__device__ __forceinline__ void wtile_finish(const WTile& t, int tid, lds_u8* sm, const f32x4 (&v)[8], const float (&rs)[8]) {
    LAS float* sT = (LAS float*)sm;
    const int c4 = tid & 63, r0 = tid >> 6, nd = t.nt * 256 + 4 * c4;
    const float cs = (t.mode && (nd < 512 || (nd >= 1536 && nd < 2048))) ? QSCALE : 1.0f;
#pragma unroll
    for (int i = 0; i < 8; ++i) *(LAS f32x4*)(sT + (r0 + 8 * i) * 260 + 4 * (c4 ^ i)) = v[i] * (rs[i] * cs);
    __syncthreads();
#pragma unroll
    for (int j = 0; j < 4; ++j) {
        const int p = tid + 512 * j, nl = p >> 3, c = p & 7, n2 = t.nt * 256 + nl;
        const LAS float* q = sT + (8 * c) * 260 + 4 * ((nl >> 2) ^ c) + (nl & 3);
        u32x4 w; w.x = pk2(q[0], q[260]); w.y = pk2(q[2 * 260], q[3 * 260]); w.z = pk2(q[4 * 260], q[5 * 260]); w.w = pk2(q[6 * 260], q[7 * 260]);
        if (n2 < t.Ndst) *(u32x4*)(t.WT + (size_t)n2 * t.ldk + t.koff + t.kt * 64 + 8 * c) = w;
    }
    __syncthreads();
}

__device__ __forceinline__ void phase_weights(KParams P, int layer, lds_u8* sm, int G, int bid, int tid) {
    unsigned char* ws = P->ws;
    {
        f32x4 va[8], vb[8]; float ra[8], rb[8];
        int g0 = bid;
        if (g0 < W_NTILES) {
            WTile t0 = wtile_decode(P, layer, g0);
            wtile_issue(t0, tid, va, ra);
            for (;;) {
                const int g1 = g0 + G; const bool has1 = g1 < W_NTILES;
                WTile t1 = wtile_decode(P, layer, has1 ? g1 : g0);
                if (has1) wtile_issue(t1, tid, vb, rb);
                wtile_finish(t0, tid, sm, va, ra);
                if (!has1) break;
                g0 = g1 + G; const bool has0 = g0 < W_NTILES;
                t0 = wtile_decode(P, layer, has0 ? g0 : g1);
                if (has0) wtile_issue(t0, tid, va, ra);
                wtile_finish(t1, tid, sm, vb, rb);
                if (!has0) break;
            }
        }
    }
    for (int wb = G - 1 - bid; wb < 32; wb += G) {
        const int kv = wb >> 4, ch = wb & 15, j = tid & 255, kh = tid >> 8;
        const float* w1 = P->in[5] + (size_t)(layer * 2 + kv) * 2048 * 256;
        const float* pos = P->in[4] + (size_t)(layer * 2 + kv) * 2048;
        float a = 0.f;
        {
            const int kb = ch * 128 + kh * 64;
#pragma unroll 1
            for (int k0 = 0; k0 < 64; k0 += 16) {
                float wv[16], pv[16];
#pragma unroll
                for (int i = 0; i < 16; ++i) { wv[i] = w1[(size_t)(kb + k0 + i) * 256 + j]; pv[i] = pos[kb + k0 + i]; }
#pragma unroll
                for (int i = 0; i < 16; ++i) a += pv[i] * wv[i];
            }
        }
        LAS float* red = (LAS float*)sm;
        if (kh == 1) red[j] = a;
        __syncthreads();
        if (kh == 0) ((float*)(ws + WS_PB1))[(kv * 16 + ch) * 256 + j] = a + red[j];
        __syncthreads();
    }
}

__device__ __forceinline__ void phase_x_to_bf16(KParams P, int G, int bid, int wid, int lane) {
    const float* __restrict__ x = P->in[0]; bf16_t* __restrict__ XB = (bf16_t*)(P->ws + WS_XB); float* __restrict__ part = (float*)(P->ws + WS_PART);
    for (int row0 = bid * 8 + wid; row0 < M; row0 += 4 * G * 8) {
        f32x4 v[4][4];
#pragma unroll
        for (int k = 0; k < 4; ++k) {
            const int row = row0 + k * G * 8;
#pragma unroll
            for (int i = 0; i < 4; ++i) v[k][i] = (row < M) ? ((const f32x4*)(x + (size_t)row * DM))[lane + 64 * i] : (f32x4){0.f, 0.f, 0.f, 0.f};
        }
#pragma unroll
        for (int k = 0; k < 4; ++k) {
            const int row = row0 + k * G * 8;
            if (row < M) {
                float ss = 0.f;
#pragma unroll
                for (int i = 0; i < 4; ++i) {
                    const f32x4 t = v[k][i];
                    ss += (t[0] * t[0] + t[1] * t[1]) + (t[2] * t[2] + t[3] * t[3]);
                    u32x2 w; w.x = pk2(t[0], t[1]); w.y = pk2(t[2], t[3]);
                    *(u32x2*)(XB + (size_t)row * DM + 4 * (lane + 64 * i)) = w;
                }
                ss = wave_sum(ss);
                if (lane < 16) part[(size_t)row * 16 + lane] = (lane == 0) ? ss : 0.f;
            }
        }
    }
}

__device__ __forceinline__ void phase_prep(KParams P, int layer, lds_u8* sm, int G, int bid, int tid, int wid, int lane) {
    unsigned char* ws = P->ws;
    bf16_t* proj = (bf16_t*)(ws + WS_PROJ);
    for (int w = bid; w < 256; w += G) {
        const int bh = w >> 4, c = w & 15, b = bh >> 3, h = bh & 7, t = c * 512 + tid;
        const float z = bf2f(proj[(size_t)(b * T + t) * PC + C_F + h]) + P->in[3][layer * 8 + h];
        const float lf = fminf(z, 0.f) - log1pf(__expf(-fabsf(z)));
        LAS float* sc = (LAS float*)sm;
        sc[tid] = lf;
        __syncthreads();
        for (int o = 1; o < 512; o <<= 1) {
            float v = sc[tid]; if (tid >= o) v += sc[tid - o];
            __syncthreads(); sc[tid] = v; __syncthreads();
        }
        const float pfx = sc[tid] * LOG2E;
        ((float*)(ws + WS_CUM))[(size_t)bh * T + t] = pfx;
        if (tid == 511) ((float*)(ws + WS_TOT))[bh * 16 + c] = pfx;
        __syncthreads();
    }
    for (int item = bid * 8 + wid; item < 16 * 128; item += G * 8) {
        const int bh = item >> 7, jt = item & 127, b = bh >> 3, h = bh & 7;
        const u32x4* kp = (const u32x4*)(proj + (size_t)(b * T + 64 * jt + lane) * PC + C_KA + h * 64);
        float ss = 0.f;
#pragma unroll
        for (int c = 0; c < 8; ++c) { const u32x4 w = kp[c];
#pragma unroll
            for (int e = 0; e < 4; ++e) { const float lo = bflo(w[e]), hi2 = bfhi(w[e]); ss += lo * lo + hi2 * hi2; } }
#pragma unroll
        for (int o = 32; o >= 1; o >>= 1) ss = fmaxf(ss, __shfl_xor(ss, o));
        if (lane == 0) ((float*)(ws + WS_KNT))[item] = sqrtf(ss) * 1.0001f;
    }
    for (int idx = bid * 512 + tid; idx < M * 12; idx += G * 512) {
        const int row = idx / 12, hh = idx - row * 12, pos = row & (T - 1);
        const int col = hh < 8 ? C_QB + hh * 64 : (hh < 10 ? C_KS + (hh - 8) * 64 : C_KW + (hh - 10) * 64);
        u32x4* p = (u32x4*)(proj + (size_t)row * PC + col);
        const u32x4 a = p[0], b = p[1];
        u32x4 oa, ob;
#pragma unroll
        for (int w = 0; w < 4; ++w) {
            float cs0, sn0, cs1, sn1; rope_cs(pos, 2 * w, cs0, sn0); rope_cs(pos, 2 * w + 1, cs1, sn1);
            const float x10 = bflo(a[w]), x11 = bfhi(a[w]), x20 = bflo(b[w]), x21 = bfhi(b[w]);
            oa[w] = pk2(x10 * cs0 - x20 * sn0, x11 * cs1 - x21 * sn1);
            ob[w] = pk2(x20 * cs0 + x10 * sn0, x21 * cs1 + x11 * sn1);
        }
        p[0] = oa; p[1] = ob;
    }
    for (int u = bid; u < 256; u += G) {
        const int kv = u >> 7, bg = (u >> 5) & 3, rt = u & 31, b = bg >> 1, g = bg & 1;
        const int col0 = (kv ? C_VC : C_KC) + g * 64, fr = lane & 15, kq = lane >> 4;
        int nld = rt * 16 + fr; if (nld > 510) nld = 510;
        const bf16_t* Ab = proj + (size_t)(b * T + 16 * nld) * PC + col0;
        const bf16_t* Bb = (const bf16_t*)(ws + WS_WC1) + (size_t)kv * 256 * 2048 + (size_t)fr * 2048;
        f32x4 acc[16];
#pragma unroll
        for (int j = 0; j < 16; ++j) acc[j] = (f32x4){0.f, 0.f, 0.f, 0.f};
#pragma unroll 1
        for (int ks = 0; ks < 8; ++ks) {
            const int k0 = 256 * wid + 32 * ks, l = k0 >> 6, d0 = (k0 & 63) + 8 * kq;
            const bf16x8 a = *(const bf16x8*)(Ab + (size_t)l * PC + d0);
#pragma unroll
            for (int jt = 0; jt < 16; ++jt) {
                const bf16x8 bb = *(const bf16x8*)(Bb + (size_t)jt * 16 * 2048 + k0 + 8 * kq);
                acc[jt] = __builtin_amdgcn_mfma_f32_16x16x32_bf16(a, bb, acc[jt], 0, 0, 0);
                if ((jt & 7) == 7) asm volatile("" ::: "memory");
            }
        }
        LAS float* red = (LAS float*)sm;
#pragma unroll 1
        for (int w = 0; w < 8; ++w) {
            if (wid == w) {
#pragma unroll
                for (int jt = 0; jt < 16; ++jt)
#pragma unroll
                    for (int r = 0; r < 4; ++r) { const int ix = (4 * kq + r) * 256 + 16 * jt + fr; if (w == 0) red[ix] = acc[jt][r]; else red[ix] += acc[jt][r]; }
            }
            __syncthreads();
        }
        LAS bf16_t* hid = (LAS bf16_t*)(sm + 16384);
        LAS float* outb = (LAS float*)(sm + 16384 + 8448);
        {
            const int j = tid & 255;
            const float* pb1 = (const float*)(ws + WS_PB1) + kv * 16 * 256 + j;
            float bias = P->in[6][(layer * 2 + kv) * 256 + j];
#pragma unroll
            for (int c = 0; c < 16; ++c) bias += pb1[c * 256];
#pragma unroll
            for (int i = 0; i < 8; ++i) {
                const int e = tid + 512 * i, row = e >> 8;
                const float x = red[e] + bias;
                const float uu = 0.7978845608028654f * (x + 0.044715f * x * x * x);
                const float th = 1.0f - 2.0f / (__expf(2.0f * uu) + 1.0f);
                const float gl = 0.5f * x * (1.0f + th);
                hid[row * 264 + j] = (bf16_t)(pk2(gl, 0.f) & 0xffffu);
            }
        }
        __syncthreads();
        if (wid < 4) {
            f32x4 a2 = (f32x4){0.f, 0.f, 0.f, 0.f};
            const bf16_t* B2 = (const bf16_t*)(ws + WS_WC2) + (size_t)kv * 64 * 256 + (size_t)(16 * wid + fr) * 256;
#pragma unroll
            for (int ks = 0; ks < 8; ++ks) {
                const bf16x8 a = *(const LAS bf16x8*)(hid + fr * 264 + 32 * ks + 8 * kq);
                const bf16x8 bb = *(const bf16x8*)(B2 + 32 * ks + 8 * kq);
                a2 = __builtin_amdgcn_mfma_f32_16x16x32_bf16(a, bb, a2, 0, 0, 0);
            }
            const float b2 = P->in[8][(layer * 2 + kv) * 64 + 16 * wid + fr];
#pragma unroll
            for (int r = 0; r < 4; ++r) outb[(4 * kq + r) * 64 + 16 * wid + fr] = a2[r] + b2;
        }
        __syncthreads();
        bf16_t* KCV = (bf16_t*)(ws + WS_KC) + (size_t)(kv * 4 + bg) * 512 * 64;
#pragma unroll
        for (int i = 0; i < 2; ++i) {
            const int e = tid + 512 * i, row = e >> 6, c = e & 63, n = rt * 16 + row;
            float v = outb[e];
            if (kv == 0 && c < 16) {
                const int i8 = c & 7; const float x1 = outb[row * 64 + i8], x2 = outb[row * 64 + 8 + i8];
                float cs, sn; rope_cs(16 * n + 31, i8, cs, sn);
                v = c < 8 ? x1 * cs - x2 * sn : x2 * cs + x1 * sn;
            }
            if (n >= 511) v = 0.f;
            if (kv == 0) KCV[(size_t)n * 64 + c] = (bf16_t)(pk2(v, 0.f) & 0xffffu);
            else KCV[(size_t)(n >> 6) * 4096 + c * 64 + vt_pos(n & 63)] = (bf16_t)(pk2(v, 0.f) & 0xffffu);
        }
        __syncthreads();
    }
}

constexpr int A_STAGE = 18688  , A_IMP = 3 * A_STAGE, A_OPART = A_IMP  , A_SELM = A_IMP + 65536, A_TL = A_SELM + 1024, A_END = A_TL + 528;
static_assert(A_END + 64 <= 131072 && 64 * 129 * 4 <= 65536, "attention LDS map");
struct FS { f32x16 o0, o1; float m, l; };
__device__ __forceinline__ void fs_init(FS& s) {
#pragma unroll
    for (int r = 0; r < 16; ++r) { s.o0[r] = 0.f; s.o1[r] = 0.f; }
    s.m = -1e30f; s.l = 0.f;
}
struct MaskCtx { int qpos; int diag0; int cur; unsigned mw0, mw1, mw2, mw3; };

__device__ __forceinline__ float xhalf_max(float v) { auto rr = __builtin_amdgcn_permlane32_swap(__float_as_uint(v), __float_as_uint(v), false, false); return fmaxf(__uint_as_float(rr[0]), __uint_as_float(rr[1])); }
__device__ __forceinline__ float xhalf_sum(float v) { auto rr = __builtin_amdgcn_permlane32_swap(__float_as_uint(v), __float_as_uint(v), false, false); return __uint_as_float(rr[0]) + __uint_as_float(rr[1]); }

#define LDS_BARRIER() asm volatile("s_waitcnt lgkmcnt(0)\n\ts_barrier" ::: "memory")
__device__ __forceinline__ float quad_sum(float v) {
    v += __uint_as_float((unsigned)__builtin_amdgcn_update_dpp(0, (int)__float_as_uint(v), 0xB1, 0xF, 0xF, false));
    v += __uint_as_float((unsigned)__builtin_amdgcn_update_dpp(0, (int)__float_as_uint(v), 0x4E, 0xF, 0xF, false));
    return v;
}
__device__ __forceinline__ int oct_sum(int v) {
    v += __builtin_amdgcn_update_dpp(0, v, 0xB1, 0xF, 0xF, false);
    v += __builtin_amdgcn_update_dpp(0, v, 0x4E, 0xF, 0xF, false);
    v += __builtin_amdgcn_update_dpp(0, v, 0x141, 0xF, 0xF, false);
    return v;
}
template <int MODE, int PASS>
__device__ __forceinline__ void flash_run(lds_u8* sm, const bf16_t* __restrict__ Kg, const bf16_t* __restrict__ Vg, int pitch, int first, int nt, bool uselist, const LAS int* list,
                                          const float* __restrict__ cum, float cref, const bf16x8 (&qf)[4], FS& st, const MaskCtx& mc, int tid, int lane, int qloc) {
    if (nt <= 0) return;
    const int r32 = lane & 31, hi = lane >> 5;
    const int krow = tid >> 3, kch = tid & 7;
    u32x4 rkA, rvA, rkB, rvB; float rcA = 0.f, rcB = 0.f;
    float invl = 0.f;
    if (PASS == 2) invl = st.l > 0.f ? 1.0f / st.l : 0.f;
    auto tile_of = [&](int i) -> int { return uselist ? list[i] : first + i; };
    auto gload = [&](int jt, u32x4& rk, u32x4& rv, float& rc) {
        rk = *(const u32x4*)(Kg + (size_t)(64 * jt + krow) * pitch + kch * 8);
        if (PASS != 1) rv = *(const u32x4*)(Vg + (size_t)(64 * jt + krow) * pitch + kch * 8);
        if (MODE == 0) { if (tid < 64) rc = cref - (cum[64 * jt + tid] + ((const LAS float*)(sm + A_SELM))[16 + (jt >> 3)]); }
    };
    auto lstore = [&](int buf, const u32x4& rk, const u32x4& rv, float rc) {
        lds_u8* bb = sm + buf * A_STAGE;
        *(LAS u32x4*)(bb + krow * 144 + kch * 16) = rk;
        if (PASS != 1) *(LAS u32x4*)(bb + 9216 + krow * 144 + kch * 16) = rv;
        if (MODE == 0) {
            if (tid < 64) {
                const unsigned hb = pk2(rc, 0.f) & 0xffffu; const float lo = rc - bflo(hb);
                *(LAS u32x4*)(bb + tid * 144 + 128) = (u32x4){hb | (pk2(lo, 0.f) << 16), 0u, 0u, 0u};
            }
        }
    };
    f32x16 negm;
#pragma unroll
    for (int r = 0; r < 16; ++r) negm[r] = (PASS == 2) ? -st.m : 0.f;
    if (PASS != 2) st.m = 0.f;
    auto smm = [&](int buf, f32x16& d0, f32x16& d1) {
        const lds_u8* Ks = sm + buf * A_STAGE;
        bf16x8 kf[8];
#pragma unroll
        for (int s = 0; s < 4; ++s) {
            kf[2 * s]     = *(const LAS bf16x8*)(Ks + r32 * 144 + (16 * s + 8 * hi) * 2);
            kf[2 * s + 1] = *(const LAS bf16x8*)(Ks + (r32 + 32) * 144 + (16 * s + 8 * hi) * 2);
        }
        __builtin_amdgcn_sched_barrier(0);
        d0 = __builtin_amdgcn_mfma_f32_32x32x16_bf16(kf[0], qf[0], negm, 0, 0, 0); d1 = __builtin_amdgcn_mfma_f32_32x32x16_bf16(kf[1], qf[0], negm, 0, 0, 0);
#pragma unroll
        for (int s = 1; s < 4; ++s) { d0 = __builtin_amdgcn_mfma_f32_32x32x16_bf16(kf[2 * s], qf[s], d0, 0, 0, 0); d1 = __builtin_amdgcn_mfma_f32_32x32x16_bf16(kf[2 * s + 1], qf[s], d1, 0, 0, 0); }
        if (MODE == 0) {
            const bf16x8 b0 = *(const LAS bf16x8*)(Ks + r32 * 144 + 128 + 16 * hi), b1 = *(const LAS bf16x8*)(Ks + (r32 + 32) * 144 + 128 + 16 * hi);
            const short one = hi ? (short)0 : (short)0x3F80;
            const bf16x8 qb1 = (bf16x8){one, one, 0, 0, 0, 0, 0, 0};
            d0 = __builtin_amdgcn_mfma_f32_32x32x16_bf16(b0, qb1, d0, 0, 0, 0); d1 = __builtin_amdgcn_mfma_f32_32x32x16_bf16(b1, qb1, d1, 0, 0, 0);
        }
        __builtin_amdgcn_sched_barrier(0);
    };
    auto softpv = [&](int jt, int buf, f32x16& p0, f32x16& p1, f32x16& pn0, f32x16& pn1, bool has_next) {
        const lds_u8* Vt = sm + buf * A_STAGE + 9216;
        const LAS float* cb = (const LAS float*)(sm + buf * A_STAGE + 18432);
        const float NEG = -INFINITY;
        bool selbit = true;
        if (MODE == 2) { const unsigned w = ((const LAS unsigned*)(sm + A_SELM))[qloc * 4 + (jt >> 5)]; selbit = (w >> (jt & 31)) & 1u; }
        bool need = false;
        if (MODE == 0) need = jt >= mc.diag0;
        if (MODE == 1) need = 16 * (64 * jt + 63) + 31 > mc.diag0;
        if (MODE == 2) need = jt == mc.cur;
        if (MODE == 3) need = (jt == mc.cur) || (jt + 8 == mc.cur);
        if (need) {
#pragma unroll
            for (int r = 0; r < 16; ++r) {
                const int kl = (r & 3) + 8 * (r >> 2) + 4 * hi, k0 = 64 * jt + kl, k1 = k0 + 32;
                float s0 = p0[r], s1 = p1[r];
                if (MODE == 0 || MODE == 2) { if (k0 > mc.qpos) s0 = NEG; if (k1 > mc.qpos) s1 = NEG; }
                if (MODE == 1) { if (16 * k0 + 31 > mc.qpos) s0 = NEG; if (16 * k1 + 31 > mc.qpos) s1 = NEG; }
                if (MODE == 3) { if (k0 > mc.qpos || mc.qpos - k0 >= 512) s0 = NEG; if (k1 > mc.qpos || mc.qpos - k1 >= 512) s1 = NEG; }
                p0[r] = s0; p1[r] = s1;
            }
        }
        if (PASS != 2) {
            float m0 = __builtin_fmaxf(__builtin_fmaxf(p0[0], p0[1]), p0[2]), m1 = __builtin_fmaxf(__builtin_fmaxf(p1[0], p1[1]), p1[2]);
#pragma unroll
            for (int r = 3; r < 15; r += 2) { m0 = __builtin_fmaxf(__builtin_fmaxf(m0, p0[r]), p0[r + 1]); m1 = __builtin_fmaxf(__builtin_fmaxf(m1, p1[r]), p1[r + 1]); }
            float mx = __builtin_fmaxf(__builtin_fmaxf(m0, m1), __builtin_fmaxf(p0[15], p1[15]));
            mx = xhalf_max(mx);
            if (MODE == 2) mx = selbit ? mx : NEG;
            if (__any(mx > 8.0f)) {
                const float d = fmaxf(mx, 0.f), al = __builtin_amdgcn_exp2f(-d);
                st.m += d; st.l *= al;
#pragma unroll
                for (int r = 0; r < 16; ++r) { p0[r] -= d; p1[r] -= d; negm[r] -= d; }
                if (has_next) {
#pragma unroll
                    for (int r = 0; r < 16; ++r) { pn0[r] -= d; pn1[r] -= d; }
                }
                if (PASS == 0) {
#pragma unroll
                    for (int r = 0; r < 16; ++r) { st.o0[r] *= al; st.o1[r] *= al; }
                }
            }
            f32x2 acc2 = {0.f, 0.f};
#pragma unroll
            for (int r = 0; r < 16; r += 2) {
                p0[r] = __builtin_amdgcn_exp2f(p0[r]); p0[r + 1] = __builtin_amdgcn_exp2f(p0[r + 1]); p1[r] = __builtin_amdgcn_exp2f(p1[r]); p1[r + 1] = __builtin_amdgcn_exp2f(p1[r + 1]);
                acc2 += (f32x2){p0[r], p0[r + 1]}; acc2 += (f32x2){p1[r], p1[r + 1]};
            }
            float sum = xhalf_sum(acc2.x + acc2.y);
            if (MODE == 2) sum = selbit ? sum : 0.f;
            st.l += sum;
        } else {
#pragma unroll
            for (int r = 0; r < 16; ++r) { p0[r] = __builtin_amdgcn_exp2f(p0[r]) * invl; p1[r] = __builtin_amdgcn_exp2f(p1[r]) * invl; }
            float A[8], H[8];
#pragma unroll
            for (int g8 = 0; g8 < 8; ++g8) {
                const int hf = g8 >> 2, u4 = g8 & 3;
                const float x0 = hf ? p1[4 * u4] : p0[4 * u4], x1 = hf ? p1[4 * u4 + 1] : p0[4 * u4 + 1], x2 = hf ? p1[4 * u4 + 2] : p0[4 * u4 + 2], x3 = hf ? p1[4 * u4 + 3] : p0[4 * u4 + 3];
                A[g8] = quad_sum((x0 + x1) + (x2 + 0.5f * x3)); H[g8] = quad_sum(0.5f * x3);
            }
            float W[17];
#pragma unroll
            for (int g8 = 0; g8 < 8; ++g8) {
                const auto ra = __builtin_amdgcn_permlane32_swap(__float_as_uint(A[g8]), __float_as_uint(A[g8]), false, false);
                const auto rh = __builtin_amdgcn_permlane32_swap(__float_as_uint(H[g8]), __float_as_uint(H[g8]), false, false);
                const float a0 = __uint_as_float(ra[0]), a1 = __uint_as_float(ra[1]), h0 = __uint_as_float(rh[0]), h1 = __uint_as_float(rh[1]);
                if (g8 == 0) W[0] = a0; else W[2 * g8] += a0;
                W[2 * g8 + 1] = h0 + a1; W[2 * g8 + 2] = h1;
            }
            if ((lane & 35) == 0) {
                LAS float* imp = (LAS float*)(sm + A_IMP) + qloc * 129 + 16 * jt;
#pragma unroll
                for (int k = 0; k < 17; ++k) imp[k] += W[k];
            }
        }
        if (PASS != 1) {
            const unsigned pmask = (MODE == 2) ? (selbit ? 0xffffffffu : 0u) : 0xffffffffu;
            bf16x8 pb[4];
#pragma unroll
            for (int sp = 0; sp < 4; ++sp) {
                const int rb = (sp & 1) * 8;
                u32x4 pw;
                if (sp < 2) { pw.x = pk2(p0[rb], p0[rb + 1]); pw.y = pk2(p0[rb + 2], p0[rb + 3]); pw.z = pk2(p0[rb + 4], p0[rb + 5]); pw.w = pk2(p0[rb + 6], p0[rb + 7]); }
                else        { pw.x = pk2(p1[rb], p1[rb + 1]); pw.y = pk2(p1[rb + 2], p1[rb + 3]); pw.z = pk2(p1[rb + 4], p1[rb + 5]); pw.w = pk2(p1[rb + 6], p1[rb + 7]); }
                if (MODE == 2) { pw.x &= pmask; pw.y &= pmask; pw.z &= pmask; pw.w &= pmask; }
                pb[sp] = __builtin_bit_cast(bf16x8, pw);
            }
#pragma unroll
            for (int dh = 0; dh < 2; ++dh) {
                bf16x8 vf[4];
#pragma unroll
                for (int sp = 0; sp < 4; ++sp) {
                    const int kvb = (sp & 1) * 16 + (sp >> 1) * 32;
                    vf[sp] = *(const LAS bf16x8*)(Vt + (r32 + 32 * dh) * 144 + (kvb + 8 * hi) * 2);
                }
                __builtin_amdgcn_sched_barrier(0);
#pragma unroll
                for (int sp = 0; sp < 4; ++sp) {
                    if (dh == 0) st.o0 = __builtin_amdgcn_mfma_f32_32x32x16_bf16(vf[sp], pb[sp], st.o0, 0, 0, 0);
                    else         st.o1 = __builtin_amdgcn_mfma_f32_32x32x16_bf16(vf[sp], pb[sp], st.o1, 0, 0, 0);
                }
                __builtin_amdgcn_sched_barrier(0);
            }
        }
    };
    gload(tile_of(0), rkA, rvA, rcA);
    if (nt > 1) gload(tile_of(1), rkB, rvB, rcB);
    lstore(0, rkA, rvA, rcA);
    if (nt > 1) lstore(1, rkB, rvB, rcB);
    if (nt > 2) gload(tile_of(2), rkA, rvA, rcA);
    LDS_BARRIER();
    auto wave_active = [&](int jt) -> bool {
        if (MODE != 2) return true;
        const unsigned w = ((const LAS unsigned*)(sm + A_SELM))[qloc * 4 + (jt >> 5)];
        return __any((w >> (jt & 31)) & 1u) != 0;
    };
    f32x16 pa0, pa1;
    int b0 = 0;
    for (int i = 0; i < nt; i += 2) {
        int b1 = b0 + 1; if (b1 == 3) b1 = 0; int b2 = b1 + 1; if (b2 == 3) b2 = 0;
        if (i + 3 < nt) gload(tile_of(i + 3), rkB, rvB, rcB);
        if (wave_active(tile_of(i))) { smm(b0, pa0, pa1); softpv(tile_of(i), b0, pa0, pa1, pa0, pa1, false); }
        if (i + 2 < nt) lstore(b2, rkA, rvA, rcA);
        LDS_BARRIER();
        if (i + 1 >= nt) break;
        if (i + 4 < nt) gload(tile_of(i + 4), rkA, rvA, rcA);
        if (wave_active(tile_of(i + 1))) { smm(b1, pa0, pa1); softpv(tile_of(i + 1), b1, pa0, pa1, pa0, pa1, false); }
        if (i + 3 < nt) lstore(b0, rkB, rvB, rcB);
        LDS_BARRIER();
        b0 = b2;
    }
}

__device__ __forceinline__ void load_q(bf16x8 (&qf)[4], const bf16_t* qrow, int hi) {
#pragma unroll
    for (int s = 0; s < 4; ++s) qf[s] = *(const bf16x8*)(qrow + 16 * s + 8 * hi);
}
__device__ __forceinline__ void store_o(bf16_t* orow, const f32x16& v0, const f32x16& v1, int hi) {
#pragma unroll
    for (int g4 = 0; g4 < 4; ++g4) {
        u32x2 a, b; a.x = pk2(v0[4 * g4], v0[4 * g4 + 1]); a.y = pk2(v0[4 * g4 + 2], v0[4 * g4 + 3]); b.x = pk2(v1[4 * g4], v1[4 * g4 + 1]); b.y = pk2(v1[4 * g4 + 2], v1[4 * g4 + 3]);
        *(u32x2*)(orow + 8 * g4 + 4 * hi) = a; *(u32x2*)(orow + 32 + 8 * g4 + 4 * hi) = b;
    }
}

__device__ __forceinline__ void oacc_store(float* orow, const f32x16& v0, const f32x16& v1, int hi) {
#pragma unroll
    for (int g4 = 0; g4 < 4; ++g4) {
        *(f32x4*)(orow + 8 * g4 + 4 * hi) = (f32x4){v0[4 * g4], v0[4 * g4 + 1], v0[4 * g4 + 2], v0[4 * g4 + 3]};
        *(f32x4*)(orow + 32 + 8 * g4 + 4 * hi) = (f32x4){v1[4 * g4], v1[4 * g4 + 1], v1[4 * g4 + 2], v1[4 * g4 + 3]};
    }
}
__device__ __forceinline__ void oacc_add(const float* orow, f32x16& v0, f32x16& v1, int hi) {
#pragma unroll
    for (int g4 = 0; g4 < 4; ++g4) {
        const f32x4 a = *(const f32x4*)(orow + 8 * g4 + 4 * hi), b = *(const f32x4*)(orow + 32 + 8 * g4 + 4 * hi);
#pragma unroll
        for (int e = 0; e < 4; ++e) { v0[4 * g4 + e] += a[e]; v1[4 * g4 + e] += b[e]; }
    }
}

__device__ __forceinline__ void opart_store(lds_u8* sm, int tid, const f32x16& v0, const f32x16& v1) {
#pragma unroll
    for (int g4 = 0; g4 < 4; ++g4) {
        *(LAS f32x4*)(sm + A_OPART + (g4 * 512 + tid) * 16) = (f32x4){v0[4 * g4], v0[4 * g4 + 1], v0[4 * g4 + 2], v0[4 * g4 + 3]};
        *(LAS f32x4*)(sm + A_OPART + ((4 + g4) * 512 + tid) * 16) = (f32x4){v1[4 * g4], v1[4 * g4 + 1], v1[4 * g4 + 2], v1[4 * g4 + 3]};
    }
}
__device__ __forceinline__ void opart_add(const lds_u8* sm, int tid, f32x16& v0, f32x16& v1) {
#pragma unroll
    for (int g4 = 0; g4 < 4; ++g4) {
        const f32x4 a = *(const LAS f32x4*)(sm + A_OPART + (g4 * 512 + tid) * 16), b = *(const LAS f32x4*)(sm + A_OPART + ((4 + g4) * 512 + tid) * 16);
#pragma unroll
        for (int e = 0; e < 4; ++e) { v0[4 * g4 + e] += a[e]; v1[4 * g4 + e] += b[e]; }
    }
}

__device__ __forceinline__ void fox_unit(KParams P, lds_u8* sm, int bh0, int qb0, int tid0, int wid, int lane0) {
    int bh = bh0, qb = qb0; asm volatile("" : "+s"(bh), "+s"(qb));
    int tid = tid0; asm volatile("" : "+v"(tid)); const int lane = tid & 63;
    const bf16_t* proj = (const bf16_t*)(P->ws + WS_PROJ);
    const int b = bh >> 3, h = bh & 7, r32 = lane & 31, hi = lane >> 5;
    const int q = qb * 256 + 32 * wid + r32;
    bf16x8 qf[4]; load_q(qf, proj + (size_t)(b * T + q) * PC + C_QA + h * 64, hi);
    const float* cum = (const float*)(P->ws + WS_CUM) + (size_t)bh * T;
    const float* tot = (const float*)(P->ws + WS_TOT) + bh * 16;
    LAS float* offs = (LAS float*)(sm + A_SELM) + 16;
    if (tid < 16) {
        float tv[15];
#pragma unroll
        for (int c = 0; c < 15; ++c) tv[c] = tot[c];
        float o = 0.f;
#pragma unroll
        for (int c = 0; c < 15; ++c) o += (c < tid) ? tv[c] : 0.f;
        offs[tid] = o;
    }
    float offq = 0.f;
    {
        float tv[15];
#pragma unroll
        for (int c = 0; c < 15; ++c) tv[c] = tot[c];
#pragma unroll
        for (int c = 0; c < 15; ++c) offq += (c < (qb >> 1)) ? tv[c] : 0.f;
    }
    const float cref = cum[qb * 256] + offq;
    FS st; fs_init(st);
    MaskCtx mc; mc.qpos = q; mc.diag0 = 4 * qb; mc.cur = 0; mc.mw0 = mc.mw1 = mc.mw2 = mc.mw3 = 0u;
    {
        bf16x8 kf[4]; load_q(kf, proj + (size_t)(b * T + q) * PC + C_KA + h * 64, hi);
        float qq = 0.f, qk = 0.f;
#pragma unroll
        for (int s4 = 0; s4 < 4; ++s4)
#pragma unroll
            for (int e = 0; e < 8; ++e) { const float a = bf2f((unsigned short)qf[s4][e]), kk = bf2f((unsigned short)kf[s4][e]); qq += a * a; qk += a * kk; }
        qq += __shfl_xor(qq, 32); qk += __shfl_xor(qk, 32);
        float qn = sqrtf(qq) * 1.0001f, bm = (cum[q] + offq) - qk;
#pragma unroll
        for (int o = 16; o >= 1; o >>= 1) { qn = fmaxf(qn, __shfl_xor(qn, o)); bm = fmaxf(bm, __shfl_xor(bm, o)); }
        LAS float* red = (LAS float*)(sm + A_SELM);
        if (lane == 0) { red[wid] = qn; red[8 + wid] = bm; }
        __syncthreads();
        if (wid == 0) {
            float QN = red[0], BM = red[8];
#pragma unroll
            for (int w = 1; w < 8; ++w) { QN = fmaxf(QN, red[w]); BM = fmaxf(BM, red[8 + w]); }
            const float* knt = (const float*)(P->ws + WS_KNT) + bh * 128;
            LAS int* tl = (LAS int*)(sm + A_TL);
            int base = 0;
#pragma unroll
            for (int hf = 0; hf < 2; ++hf) {
                const int jt = lane + 64 * hf;
                bool keep = false;
                if (jt < 4 * qb) keep = !(QN * knt[jt] + BM - (cum[64 * jt + 63] + offs[jt >> 3]) < -48.0f);
                else if (jt < 4 * qb + 4) keep = true;
                const unsigned long long mk = __ballot(keep);
                if (keep) tl[1 + base + __popcll(mk & ((1ull << lane) - 1ull))] = jt;
                base += __popcll(mk);
            }
            if (lane == 0) tl[0] = base;
        }
        __syncthreads();
    }
    {
        const LAS int* tl = (const LAS int*)(sm + A_TL);
        flash_run<0, 0>(sm, proj + (size_t)(b * T) * PC + C_KA + h * 64, proj + (size_t)(b * T) * PC + C_VA + h * 64, PC, 0, tl[0], true, tl + 1, cum, cref, qf, st, mc, tid, lane, 0);
    }
    const float il = st.l > 0.f ? 1.0f / st.l : 0.f;
    st.o0 *= il; st.o1 *= il;
    store_o((bf16_t*)(P->ws + WS_OA) + (size_t)(b * T + q) * 1024 + h * 64, st.o0, st.o1, hi);
}

__device__ __forceinline__ void nsa_unit(KParams P, lds_u8* sm, int bg0, int qt0, int tid0, int wid, int lane0) {
    int bg = bg0, qt = qt0; asm volatile("" : "+s"(bg), "+s"(qt));
    int tid = tid0; asm volatile("" : "+v"(tid)); const int lane = tid & 63;
    const bf16_t* proj = (const bf16_t*)(P->ws + WS_PROJ);
    const int b = bg >> 1, g = bg & 1, r32 = lane & 31, hi = lane >> 5, head = r32 & 3, hq = g * 4 + head;
    const int qloc = 8 * wid + (r32 >> 2), q = qt * 64 + qloc;
    const size_t prow = (size_t)(b * T + q) * PC;
    bf16x8 qf[4]; load_q(qf, proj + prow + C_QB + hq * 64, hi);
#define NSA_GATE(br) sigmoidf_(bf2f(proj[(size_t)(b * T + q) * PC + C_G3 + hq * 3 + (br)]))
#define NSA_OACC ((float*)(P->ws + WS_MIX) + (size_t)(b * T + q) * 512 + hq * 64)
    MaskCtx mc; mc.qpos = q; mc.diag0 = qt * 64; mc.cur = qt; mc.mw0 = mc.mw1 = mc.mw2 = mc.mw3 = 0u;
    for (int e = tid; e < 64 * 129; e += 512) ((LAS float*)(sm + A_IMP))[e] = 0.f;
    if (tid < 256) ((LAS unsigned*)(sm + A_SELM))[tid] = 0u;
    __syncthreads();
    f32x16 oc0, oc1;
    {
        const bf16_t* KC = (const bf16_t*)(P->ws + WS_KC) + (size_t)(0 * 4 + bg) * 512 * 64;
        const bf16_t* VC = (const bf16_t*)(P->ws + WS_KC) + (size_t)(1 * 4 + bg) * 512 * 64;
        const int ntc = (4 * qt + 3 + 63) >> 6;
        FS st;
        int repc_ = REP_CMP; asm volatile("" : "+s"(repc_));
#pragma unroll 1
        for (int rc_ = 0; rc_ < repc_; ++rc_) {
        fs_init(st);
        flash_run<1, 1>(sm, KC, VC, 64, 0, ntc, false, (const LAS int*)(sm + A_TL), nullptr, 0.f, qf, st, mc, tid, lane, qloc);
        flash_run<1, 2>(sm, KC, VC, 64, 0, ntc, false, (const LAS int*)(sm + A_TL), nullptr, 0.f, qf, st, mc, tid, lane, qloc);
        }
        const float g0 = NSA_GATE(0); oc0 = st.o0 * g0; oc1 = st.o1 * g0;
    }
    { int reps_ = REP_TOPK; asm volatile("" : "+s"(reps_));
#pragma unroll 1
    for (int rep_ = 0; rep_ < reps_; ++rep_)
    {
        const int ql = tid >> 3, sub = tid & 7, cur = qt;
        const LAS float* imp = (const LAS float*)(sm + A_IMP) + ql * 129;
        unsigned vb[16];
#pragma unroll
        for (int i = 0; i < 16; ++i) { const int s = sub * 16 + i; const float v = (s == 0 || s == cur) ? 1e6f : imp[s]; vb[i] = (s <= cur) ? __float_as_uint(v) : 0u; }
        unsigned bits = 0u;
        if (cur < 16) {
#pragma unroll
            for (int i = 0; i < 16; ++i) { if (sub * 16 + i <= cur) bits |= 1u << i; }
        } else {
            unsigned t = 0u;
            for (int bit = 30; bit >= 0; --bit) {
                const unsigned cand = t | (1u << bit);
                int c = 0;
#pragma unroll
                for (int i = 0; i < 16; ++i) c += (vb[i] >= cand) ? 1 : 0;
                c = oct_sum(c);
                if (c >= 16) t = cand;
            }
            int cg = 0, ce = 0;
#pragma unroll
            for (int i = 0; i < 16; ++i) { cg += (vb[i] > t) ? 1 : 0; ce += (vb[i] == t) ? 1 : 0; }
            const int need = 16 - oct_sum(cg);
            int pre = 0;
#pragma unroll
            for (int k = 0; k < 7; ++k) { const int ck = __shfl(ce, (lane & ~7) + k); pre += (k < sub) ? ck : 0; }
#pragma unroll
            for (int i = 0; i < 16; ++i) {
                const bool eq = vb[i] == t;
                if (sub * 16 + i <= cur && (vb[i] > t || (eq && pre < need))) bits |= 1u << i;
                pre += eq ? 1 : 0;
            }
        }
        if (bits) __hip_atomic_fetch_or((LAS unsigned*)(sm + A_SELM) + ql * 4 + (sub >> 1), bits << ((sub & 1) * 16), __ATOMIC_RELAXED, __HIP_MEMORY_SCOPE_WORKGROUP);
    }
    }
    __syncthreads();
    opart_store(sm, tid, oc0, oc1);
    {
        const LAS unsigned* selm = (const LAS unsigned*)(sm + A_SELM);
        mc.mw0 = selm[qloc * 4 + 0]; mc.mw1 = selm[qloc * 4 + 1]; mc.mw2 = selm[qloc * 4 + 2]; mc.mw3 = selm[qloc * 4 + 3];
        if (wid == 0) {
            unsigned u0 = selm[lane * 4 + 0], u1 = selm[lane * 4 + 1], u2 = selm[lane * 4 + 2], u3 = selm[lane * 4 + 3];
#pragma unroll
            for (int o = 32; o >= 1; o >>= 1) { u0 |= __shfl_xor(u0, o); u1 |= __shfl_xor(u1, o); u2 |= __shfl_xor(u2, o); u3 |= __shfl_xor(u3, o); }
            {
                LAS int* tl = (LAS int*)(sm + A_TL);
                const unsigned wlo = (lane < 32) ? u0 : u1, whi = (lane < 32) ? u2 : u3;
                const bool k0 = (wlo >> (lane & 31)) & 1u, k1 = (whi >> (lane & 31)) & 1u;
                const unsigned long long m0 = __ballot(k0), m1 = __ballot(k1);
                const unsigned long long below = (1ull << lane) - 1ull;
                const int n0 = __popcll(m0);
                if (k0) tl[1 + __popcll(m0 & below)] = lane;
                if (k1) tl[1 + n0 + __popcll(m1 & below)] = lane + 64;
                if (lane == 0) tl[0] = n0 + __popcll(m1);
            }
        }
    }
    __syncthreads();
    {
        const LAS int* tl = (const LAS int*)(sm + A_TL);
        const int nts = tl[0];
        FS st;
        int reps_ = REP_SEL; asm volatile("" : "+s"(reps_));
#pragma unroll 1
        for (int rep_ = 0; rep_ < reps_; ++rep_) {
        fs_init(st);
        int bg2 = bg; asm volatile("" : "+s"(bg2)); const bf16_t* pj = (const bf16_t*)(P->ws + WS_PROJ) + (size_t)((bg2 >> 1) * T) * PC + (bg2 & 1) * 64;
        flash_run<2, 0>(sm, pj + C_KS, pj + C_VS, PC, 0, nts, true, tl + 1, nullptr, 0.f, qf, st, mc, tid, lane, qloc);
        }
        const float il = st.l > 0.f ? NSA_GATE(1) / st.l : 0.f;
        st.o0 *= il; st.o1 *= il; opart_add(sm, tid, st.o0, st.o1); opart_store(sm, tid, st.o0, st.o1);
    }
    {
        const int f = qt >= 8 ? qt - 8 : 0;
        FS st; fs_init(st);
        int bg2 = bg; asm volatile("" : "+s"(bg2)); const bf16_t* pj = (const bf16_t*)(P->ws + WS_PROJ) + (size_t)((bg2 >> 1) * T) * PC + (bg2 & 1) * 64;
        flash_run<3, 0>(sm, pj + C_KW, pj + C_VW, PC, f, qt - f + 1, false, (const LAS int*)(sm + A_TL), nullptr, 0.f, qf, st, mc, tid, lane, qloc);
        const float il = st.l > 0.f ? NSA_GATE(2) / st.l : 0.f;
        st.o0 *= il; st.o1 *= il; opart_add(sm, tid, st.o0, st.o1);
        store_o((bf16_t*)(P->ws + WS_OA) + (size_t)(b * T + q) * 1024 + 512 + hq * 64, st.o0, st.o1, hi);
    }
    __syncthreads();
}

__device__ __forceinline__ void phase_attention(KParams P, lds_u8* sm, int G, int bid, int tid, int wid, int lane) {
    for (int w = bid; w < 256; w += G) {
        const int bg = w >> 6, qt = w & 63;
#pragma unroll 1
        for (int k = 0; k < 2 * REP_NSA; ++k) nsa_unit(P, sm, bg, (k & 1) ? qt : 127 - qt, tid, wid, lane);
        const int bh = w >> 4, qb = w & 15;
#pragma unroll 1
        for (int k = 0; k < 2 * REP_FOX; ++k) fox_unit(P, sm, bh, (k & 1) ? qb : 31 - qb, tid, wid, lane);
    }
}

#define XB_TMO      128
#define XB_XCNT(j)  (256  + 64 * (j))
#define XB_XSUB(j)  (1280 + 64 * (j))
#define XB_XGEN(j)  (2304 + 64 * (j))
#define XB_TOP      3328
#define XB_TOPGEN   3392
#define XCD_BAR_WORDS 3456
#define XB_SPIN_CAP (1u << 18)

__device__ __forceinline__ unsigned xb_ld(unsigned* p)              { return __hip_atomic_load(p, __ATOMIC_RELAXED, __HIP_MEMORY_SCOPE_AGENT); }
__device__ __forceinline__ unsigned xb_add(unsigned* p, unsigned v) { return __hip_atomic_fetch_add(p, v, __ATOMIC_RELAXED, __HIP_MEMORY_SCOPE_AGENT); }
__device__ __forceinline__ unsigned xb_xcc_id() { return (unsigned)__builtin_amdgcn_s_getreg((3 << 11) | 20) & 0xFu; }
#define XB_SPIN(cond, bar) do { unsigned _sp = 0; while (cond) { __builtin_amdgcn_s_sleep(1); \
    if ((++_sp & 255u) == 0u) { if (xb_ld(&(bar)[XB_TMO])) break; if (_sp > XB_SPIN_CAP) { atomicAdd(&(bar)[XB_TMO], 1u); break; } } } } while (0)

struct XcdBarrier {
    unsigned* bar; unsigned x;
    volatile LAS unsigned* st;
};

__device__ __forceinline__ XcdBarrier xcd_barrier_post(unsigned* bar, volatile LAS unsigned* st) {
    XcdBarrier b; b.bar = bar; b.x = xb_xcc_id(); b.st = st;
    if (threadIdx.x == 0) (void)xb_add(&bar[XB_XCNT(b.x)], 1u);
    return b;
}
__device__ __forceinline__ void xcd_barrier_complete(unsigned* bar, unsigned x, unsigned& nloc, unsigned& nx) {
    const unsigned G = gridDim.x * gridDim.y * gridDim.z;
    unsigned sum, cnt, mine, sp = 0u;
    for (;;) {
        sum = 0u; cnt = 0u; mine = 0u;
#pragma unroll
        for (unsigned j = 0; j < 16; ++j) { const unsigned c = xb_ld(&bar[XB_XCNT(j)]); sum += c; cnt += (c > 0u) ? 1u : 0u; mine = (j == x) ? c : mine; }
        if (sum == G) break;
        __builtin_amdgcn_s_sleep(1);
        if ((++sp & 255u) == 0u) { if (xb_ld(&bar[XB_TMO])) break; if (sp > XB_SPIN_CAP) { atomicAdd(&bar[XB_TMO], 1u); break; } }
    }
    nloc = mine > 0u ? mine : 1u; nx = cnt > 0u ? cnt : 1u;
}

__device__ __forceinline__ void xcd_barrier(const XcdBarrier& b) {
    asm volatile("s_waitcnt vmcnt(0)" ::: "memory");
    __syncthreads();
    if (threadIdx.x == 0) {
        unsigned* bar = b.bar; asm volatile("" : "+s"(bar)); unsigned bx_ = b.x; asm volatile("" : "+s"(bx_));
        __builtin_amdgcn_s_waitcnt(0);
        unsigned nloc = b.st[0], nx = b.st[1];
        if (nloc == 0u) { xcd_barrier_complete(bar, bx_, nloc, nx); b.st[0] = nloc; b.st[1] = nx; }
        const unsigned old = xb_add(&bar[XB_XSUB(bx_)], 1u);
        const unsigned gen = old / nloc;
        if (old + 1u == (gen + 1u) * nloc) {
            __builtin_amdgcn_fence(__ATOMIC_RELEASE, "agent");
            asm volatile("s_waitcnt vmcnt(0)" ::: "memory");
            const unsigned og = xb_add(&bar[XB_TOP], 1u);
            const unsigned tg = og / nx;
            if (og + 1u == (tg + 1u) * nx) xb_add(&bar[XB_TOPGEN], 1u);
            else XB_SPIN(xb_ld(&bar[XB_TOPGEN]) == tg, bar);
            __builtin_amdgcn_fence(__ATOMIC_ACQUIRE, "agent");
            xb_add(&bar[XB_XGEN(bx_)], 1u);
            asm volatile("s_waitcnt vmcnt(0)" ::: "memory");
        } else {
            XB_SPIN(xb_ld(&bar[XB_XGEN(bx_)]) == gen, bar);
            __builtin_amdgcn_fence(__ATOMIC_ACQUIRE, "agent");
            asm volatile("s_waitcnt vmcnt(0)" ::: "memory");
        }
    }
    __syncthreads();
}

__global__ void __launch_bounds__(512, 2) hybrid_fwd(Params Parg) {
    extern __shared__ __attribute__((aligned(16))) unsigned char smem_raw[];
    cg::grid_group grid = cg::this_grid();
#define FRESH() KParams P = (KParams)__builtin_amdgcn_kernarg_segment_ptr(); asm volatile("" : "+s"(P)); int G = gridDim.x, bid = blockIdx.x; asm volatile("" : "+s"(G), "+s"(bid)); \
                int tid = threadIdx.x; asm volatile("" : "+v"(tid)); lds_u8* sm = (lds_u8*)smem_raw; asm volatile("" : "+s"(sm)); (void)sm; const int wid = __builtin_amdgcn_readfirstlane(tid >> 6), lane = tid & 63; unsigned char* ws = P->ws; (void)wid; (void)lane; (void)ws; (void)G; (void)bid
#define LDSP ((PG8_LAS unsigned char*)smem_raw)
    XcdBarrier xbar;
    {
        FRESH();
        volatile LAS unsigned* bst = (volatile LAS unsigned*)(sm + 131072);
        if (tid == 0) { bst[0] = 0u; bst[1] = 0u; }
        __syncthreads();
        xbar = xcd_barrier_post((unsigned*)(ws + WS_BAR), bst);
        phase_x_to_bf16(P, G, bid, wid, lane);
    }
    for (int layer = 0; layer < 2; ++layer) {
#ifndef NO_W
        { int rw_ = REP_W; asm volatile("" : "+s"(rw_));
#pragma unroll 1
          for (int r_ = 0; r_ < rw_; ++r_) { FRESH(); phase_weights(P, layer, sm, G, bid, tid); } }
#endif
        xcd_barrier(xbar);
        if (gridDim.y == 0x7fffu) grid.sync();
        {
            FRESH();
            pg8::Gemm gm; gm.A = (const bf16_t*)(ws + WS_XB); gm.Bt = (const bf16_t*)(ws + WS_WIN); gm.M = M; gm.N = NPAD; gm.K = DM;
            pg8::StaticOrder so; so.init(M, NPAD, G, bid);
            EpiScaleBf16<0> ep; ep.O = (bf16_t*)(ws + WS_PROJ); ep.ldc = PC; ep.ncols = PC; ep.part = (const float*)(ws + WS_PART);
            pg8::gemm_phase<EpiScaleBf16<0>, pg8::StaticOrder, true, true>(LDSP, gm, so, ep);
        }
        xcd_barrier(xbar);
#ifndef NO_PREP
        { FRESH(); phase_prep(P, layer, sm, G, bid, tid, wid, lane); }
#endif
        xcd_barrier(xbar);
#ifndef NO_ATT
        { FRESH(); phase_attention(P, sm, G, bid, tid, wid, lane); }
#endif
        xcd_barrier(xbar);
        {
            FRESH();
            pg8::StaticOrder so; so.init(M, DM, G, bid);
            pg8::Gemm g1; g1.A = (const bf16_t*)(ws + WS_OA); g1.Bt = (const bf16_t*)(ws + WS_WOF); g1.M = M; g1.N = DM; g1.K = DM;
            EpiGateFused e1; e1.mix = (bf16_t*)(ws + WS_MIX); e1.proj = (const bf16_t*)(ws + WS_PROJ);
            pg8::gemm_phase<EpiGateFused, pg8::StaticOrder, true, true>(LDSP, g1, so, e1);
        }
        xcd_barrier(xbar);
        {
            FRESH();
            pg8::Gemm gm; gm.A = (const bf16_t*)(ws + WS_MIX); gm.Bt = (const bf16_t*)(ws + WS_WOUT); gm.M = M; gm.N = DM; gm.K = DM;
            pg8::StaticOrder so; so.init(M, DM, G, bid);
            EpiResidual ep; ep.xi = layer == 0 ? P->in[0] : (const float*)P->out; ep.xo = P->out; ep.xb = (bf16_t*)(ws + WS_XB); ep.part = (float*)(ws + WS_PART); ep.wxb = true;
            pg8::gemm_phase<EpiResidual, pg8::StaticOrder, true, true>(LDSP, gm, so, ep);
        }
        xcd_barrier(xbar);
        {
            FRESH();
            pg8::Gemm gm; gm.A = (const bf16_t*)(ws + WS_XB); gm.Bt = (const bf16_t*)(ws + WS_WUP); gm.M = M; gm.N = DFF; gm.K = DM;
            pg8::StaticOrder so; so.init(M, DFF, G, bid);
            EpiScaleBf16<1> ep; ep.O = (bf16_t*)(ws + WS_PROJ); ep.ldc = DFF; ep.ncols = DFF; ep.part = (const float*)(ws + WS_PART);
            pg8::gemm_phase<EpiScaleBf16<1>, pg8::StaticOrder, true, true>(LDSP, gm, so, ep);
        }
        xcd_barrier(xbar);
        {
            FRESH();
            pg8::Gemm gm; gm.A = (const bf16_t*)(ws + WS_PROJ); gm.Bt = (const bf16_t*)(ws + WS_WDN); gm.M = M; gm.N = DM; gm.K = DFF;
            pg8::StaticOrder so; so.init(M, DM, G, bid);
            EpiResidual ep; ep.xi = P->out; ep.xo = P->out; ep.xb = (bf16_t*)(ws + WS_XB); ep.part = (float*)(ws + WS_PART); ep.wxb = (layer == 0);
            pg8::gemm_phase<EpiResidual, pg8::StaticOrder, true, true>(LDSP, gm, so, ep);
        }
        xcd_barrier(xbar);
    }
    {
        FRESH();
        const float* gf = P->in[15]; float* XA = P->out; const float* PART = (const float*)(ws + WS_PART);
        f32x4 gv[4];
#pragma unroll
        for (int i = 0; i < 4; ++i) gv[i] = ((const f32x4*)gf)[lane + 64 * i];
        for (int row0 = bid * 8 + wid; row0 < M; row0 += 4 * G * 8) {
            f32x4 v[4][4]; float rs[4];
#pragma unroll
            for (int k = 0; k < 4; ++k) {
                const int row = row0 + k * G * 8, rr = row < M ? row : row0;
                rs[k] = row_rstd(PART, rr);
#pragma unroll
                for (int i = 0; i < 4; ++i) v[k][i] = ((const f32x4*)(XA + (size_t)rr * DM))[lane + 64 * i];
            }
            asm volatile("" ::: "memory");
#pragma unroll
            for (int k = 0; k < 4; ++k) {
                const int row = row0 + k * G * 8;
                if (row < M) {
#pragma unroll
                    for (int i = 0; i < 4; ++i) ((f32x4*)(XA + (size_t)row * DM))[lane + 64 * i] = v[k][i] * rs[k] * gv[i];
                }
            }
        }
    }
}

extern "C" void kernel_launch(void* const* d_in, const int* in_sizes, int n_in, void* d_out, int out_size, void* d_ws, size_t ws_size, hipStream_t stream) {
    static int grid_blocks = 0;
    if (!grid_blocks) {
        int dev = 0, cus = 0, per_cu = 0;
        hipGetDevice(&dev);
        hipDeviceGetAttribute(&cus, hipDeviceAttributeMultiprocessorCount, dev);
        if (hipFuncSetAttribute((const void*)hybrid_fwd, hipFuncAttributeMaxDynamicSharedMemorySize, LDS_BYTES) != hipSuccess) fprintf(stderr, "hipFuncSetAttribute failed\n");
        hipOccupancyMaxActiveBlocksPerMultiprocessor(&per_cu, hybrid_fwd, 512, LDS_BYTES);
        if (per_cu < 1) per_cu = 1;
        grid_blocks = cus * per_cu;
        if (grid_blocks > 256) grid_blocks = 256;
    }
    if (hipMemsetAsync((char*)d_ws + WS_BAR, 0, 16384, stream) != hipSuccess) fprintf(stderr, "memset failed\n");
    Params p{};
    for (int i = 0; i < 16; ++i) p.in[i] = (const float*)d_in[i];
    p.out = (float*)d_out; p.ws = (unsigned char*)d_ws;
    void* args[] = {&p};
    hipError_t e = hipLaunchCooperativeKernel((void*)hybrid_fwd, dim3(grid_blocks), dim3(512), args, LDS_BYTES, stream);
    if (e != hipSuccess) fprintf(stderr, "cooperative launch failed: %s (grid %d)\n", hipGetErrorString(e), grid_blocks);
}
```
